# Optimizing an MI355X kernel written in HIP

```python
import math
import jax, jax.numpy as jnp
from jax import lax
import numpy as np

D_MODEL = 1024
BATCH = 8
SEQ = 4096
DEPTH = 1
DEC_BATCH = 16
DEC_SEQ = 2048
PAST_LEN = 128

GRID_W = 64
N_HEADS = 8
HEAD_DIM = 64
D_ATT = N_HEADS * HEAD_DIM
NA_KH = 8
NA_KW = 16
BAND_W = 2 * NA_KW
N_COL_BLOCKS = GRID_W // NA_KW
SSM_GROUP = 16
D_SSM = 512
N_GROUPS = D_SSM // SSM_GROUP
STATE_P = 64
DT_MIN = 1e-3
DT_MAX = 1e-1
D_FF = 2816
CONV_W = 3
D_IN = 3 * D_ATT + D_SSM + 2 * D_MODEL
EPS = 1e-6
NEG_BIG = -1e30

kernel_name = 'hybrid_natten_s5_encoder'


def rms_norm(x, g):
    x32 = x.astype(jnp.float32)
    y = x32 * lax.rsqrt(jnp.mean(x32 * x32, axis=-1, keepdims=True) + EPS) * g.astype(jnp.float32)
    return y.astype(x.dtype)


def neighborhood_attention(q, k, v, rpb):
    bsz, L = q.shape[0], q.shape[1]
    rows = L // GRID_W
    kh = min(NA_KH, rows)
    n_keys = kh * BAND_W
    scale = HEAD_DIM ** -0.5
    q5 = q.reshape(bsz, rows, GRID_W, N_HEADS, HEAD_DIM)
    k5 = k.reshape(bsz, rows, GRID_W, N_HEADS, HEAD_DIM)
    v5 = v.reshape(bsz, rows, GRID_W, N_HEADS, HEAD_DIM)
    cols = np.arange(GRID_W)
    col_start = np.clip(cols - NA_KW // 2, 0, GRID_W - NA_KW)
    band_start = np.clip(np.arange(N_COL_BLOCKS) * NA_KW - NA_KW // 2, 0, GRID_W - BAND_W)
    band_cols = band_start[:, None] + np.arange(BAND_W)
    qcol = cols.reshape(N_COL_BLOCKS, NA_KW)
    qstart = col_start[qcol][:, :, None]
    kc = band_cols[:, None, :]
    col_ok = (kc >= qstart) & (kc < qstart + NA_KW)
    dc_idx = np.clip(kc - qcol[:, :, None] + NA_KW - 1, 0, 2 * NA_KW - 2)
    mask = np.broadcast_to(col_ok[:, :, None, :], (N_COL_BLOCKS, NA_KW, kh, BAND_W)).reshape(
        N_COL_BLOCKS, NA_KW, n_keys)
    rpb32 = rpb.astype(jnp.float32)

    def one_row(args):
        r, q_r = args
        rs = jnp.clip(r - kh // 2, 0, rows - kh)
        k_r = lax.dynamic_slice_in_dim(k5, rs, kh, axis=1)
        v_r = lax.dynamic_slice_in_dim(v5, rs, kh, axis=1)
        k_b = jnp.moveaxis(k_r[:, :, band_cols], 2, 1).reshape(bsz, N_COL_BLOCKS, n_keys, N_HEADS, HEAD_DIM)
        v_b = jnp.moveaxis(v_r[:, :, band_cols], 2, 1).reshape(bsz, N_COL_BLOCKS, n_keys, N_HEADS, HEAD_DIM)
        q_b = q_r.reshape(bsz, N_COL_BLOCKS, NA_KW, N_HEADS, HEAD_DIM)
        s = jnp.einsum('bnqhd,bnkhd->bhnqk', q_b, k_b,
                       preferred_element_type=jnp.float32) * scale
        dr = rs + jnp.arange(kh) - r
        bias = rpb32[:, dr + NA_KH - 1][:, :, dc_idx]
        bias = jnp.transpose(bias, (0, 2, 3, 1, 4)).reshape(N_HEADS, N_COL_BLOCKS, NA_KW, n_keys)
        s = jnp.where(mask, s + bias, NEG_BIG)
        p = jax.nn.softmax(s, axis=-1)
        o = jnp.einsum('bhnqk,bnkhd->bnqhd', p.astype(v.dtype), v_b)
        return o.reshape(bsz, GRID_W, D_ATT)

    out = lax.map(one_row, (jnp.arange(rows), jnp.moveaxis(q5, 1, 0)))
    return jnp.moveaxis(out, 0, 1).reshape(bsz, L, D_ATT)


def _ssm_combine(left, right):
    a_l, b_l = left
    a_r, b_r = right
    return a_r * a_l, a_r * b_l + b_r


def s5_mixer(u, lam_re, lam_im, log_dt, b_re, b_im, c_re, c_im, d_skip, w_glu, b_glu):
    bsz, L = u.shape[0], u.shape[1]
    f32 = jnp.float32
    u32 = u.astype(f32).reshape(bsz, L, N_GROUPS, SSM_GROUP)
    uc = u32.astype(jnp.complex64)
    y = d_skip.astype(f32).reshape(N_GROUPS, SSM_GROUP) * u32
    for dirn, rev in enumerate((False, True)):
        lam = lax.complex(lam_re[dirn].astype(f32), lam_im[dirn].astype(f32))
        dt = jnp.exp(log_dt[dirn].astype(f32))[:, None]
        lam_bar = jnp.exp(lam * dt)
        bmat = lax.complex(b_re[dirn].astype(f32), b_im[dirn].astype(f32))
        b_bar = ((lam_bar - 1.0) / lam)[:, :, None] * bmat
        bu = jnp.einsum('blgh,gph->blgp', uc, b_bar)
        a = jnp.broadcast_to(lam_bar, bu.shape)
        _, h = lax.associative_scan(_ssm_combine, (a, bu), reverse=rev, axis=1)
        cmat = lax.complex(c_re[dirn].astype(f32), c_im[dirn].astype(f32))
        y = y + jnp.real(jnp.einsum('ghp,blgp->blgh', cmat, h))
    y = jax.nn.gelu(y.reshape(bsz, L, D_SSM))
    y = y * jax.nn.sigmoid(y @ w_glu.astype(f32) + b_glu.astype(f32))
    return y.astype(u.dtype)


def dwconv3_centred(x, w, b):
    xp = jnp.pad(x, ((0, 0), (1, 1), (0, 0)))
    return xp[:, :-2] * w[0] + xp[:, 1:-1] * w[1] + xp[:, 2:] * w[2] + b


def encoder_layer(x, g_mix_pre, g_mix_post, w_in, attn_rpb, ssm_lam_re, ssm_lam_im, ssm_log_dt,
                  ssm_b_re, ssm_b_im, ssm_c_re, ssm_c_im, ssm_d, w_glu, b_glu, w_branch_att,
                  w_branch_ssm, w_out, g_ffn_pre, g_ffn_post, w_up, conv_w, conv_b, w_down):
    bsz, L = x.shape[0], x.shape[1]
    h = rms_norm(x, g_mix_pre)
    proj = h @ w_in
    splits = np.cumsum([D_ATT, D_ATT, D_ATT, D_SSM, D_MODEL])
    q, k, v, u_ssm, gate_att, gate_ssm = jnp.split(proj, splits, axis=-1)
    q = q.reshape(bsz, L, N_HEADS, HEAD_DIM)
    k = k.reshape(bsz, L, N_HEADS, HEAD_DIM)
    v = v.reshape(bsz, L, N_HEADS, HEAD_DIM)
    att = neighborhood_attention(q, k, v, attn_rpb)
    ssm = s5_mixer(u_ssm, ssm_lam_re, ssm_lam_im, ssm_log_dt, ssm_b_re, ssm_b_im,
                   ssm_c_re, ssm_c_im, ssm_d, w_glu, b_glu)
    merged = (jax.nn.sigmoid(gate_att) * (att @ w_branch_att)
              + jax.nn.sigmoid(gate_ssm) * (ssm @ w_branch_ssm))
    x = x + rms_norm(merged @ w_out, g_mix_post)
    h = rms_norm(x, g_ffn_pre)
    up = dwconv3_centred(h @ w_up, conv_w, conv_b)
    a, b = jnp.split(up, 2, axis=-1)
    x = x + rms_norm((jax.nn.gelu(a) * b) @ w_down, g_ffn_post)
    return x


def setup_inputs(seed: int = 0) -> dict:
    key = jax.random.key(seed)
    ks = jax.random.split(key, 32)
    f32 = jnp.float32

    def nrm(k, shape, scale):
        return jax.random.normal(k, shape, f32) * scale

    n = jnp.arange(STATE_P, dtype=f32)
    return {
        'x_prompt': nrm(ks[0], (BATCH, SEQ, D_MODEL), 1.0),
        'x_sample': nrm(ks[1], (DEC_BATCH, DEC_SEQ, D_MODEL), 1.0),
        'g_mix_pre': 1.0 + nrm(ks[2], (DEPTH, D_MODEL), 0.05),
        'g_mix_post': 1.0 + nrm(ks[3], (DEPTH, D_MODEL), 0.05),
        'w_in': nrm(ks[4], (DEPTH, D_MODEL, D_IN), D_MODEL ** -0.5),
        'attn_rpb': nrm(ks[5], (DEPTH, N_HEADS, 2 * NA_KH - 1, 2 * NA_KW - 1), 0.02),
        'ssm_lam_re': -0.5 + nrm(ks[6], (DEPTH, 2, N_GROUPS, STATE_P), 0.01),
        'ssm_lam_im': math.pi * n + nrm(ks[7], (DEPTH, 2, N_GROUPS, STATE_P), 0.01),
        'ssm_log_dt': jax.random.uniform(ks[8], (DEPTH, 2, N_GROUPS), f32,
                                         minval=math.log(DT_MIN), maxval=math.log(DT_MAX)),
        'ssm_b_re': nrm(ks[9], (DEPTH, 2, N_GROUPS, STATE_P, SSM_GROUP), (2 * SSM_GROUP) ** -0.5),
        'ssm_b_im': nrm(ks[10], (DEPTH, 2, N_GROUPS, STATE_P, SSM_GROUP), (2 * SSM_GROUP) ** -0.5),
        'ssm_c_re': nrm(ks[11], (DEPTH, 2, N_GROUPS, SSM_GROUP, STATE_P), (2 * STATE_P) ** -0.5),
        'ssm_c_im': nrm(ks[12], (DEPTH, 2, N_GROUPS, SSM_GROUP, STATE_P), (2 * STATE_P) ** -0.5),
        'ssm_d': nrm(ks[13], (DEPTH, D_SSM), 1.0),
        'w_glu': nrm(ks[14], (DEPTH, D_SSM, D_SSM), D_SSM ** -0.5),
        'b_glu': nrm(ks[15], (DEPTH, D_SSM), 0.01),
        'w_branch_att': nrm(ks[16], (DEPTH, D_ATT, D_MODEL), D_ATT ** -0.5),
        'w_branch_ssm': nrm(ks[17], (DEPTH, D_SSM, D_MODEL), D_SSM ** -0.5),
        'w_out': nrm(ks[18], (DEPTH, D_MODEL, D_MODEL), D_MODEL ** -0.5),
        'g_ffn_pre': 1.0 + nrm(ks[19], (DEPTH, D_MODEL), 0.05),
        'g_ffn_post': 1.0 + nrm(ks[20], (DEPTH, D_MODEL), 0.05),
        'w_up': nrm(ks[21], (DEPTH, D_MODEL, 2 * D_FF), D_MODEL ** -0.5),
        'conv_w': nrm(ks[22], (DEPTH, CONV_W, 2 * D_FF), CONV_W ** -0.5),
        'conv_b': nrm(ks[23], (DEPTH, 2 * D_FF), 0.01),
        'w_down': nrm(ks[24], (DEPTH, D_FF, D_MODEL), D_FF ** -0.5),
    }


def reference(x_prompt, x_sample, g_mix_pre, g_mix_post, w_in, attn_rpb, ssm_lam_re, ssm_lam_im,
              ssm_log_dt, ssm_b_re, ssm_b_im, ssm_c_re, ssm_c_im, ssm_d, w_glu, b_glu, w_branch_att,
              w_branch_ssm, w_out, g_ffn_pre, g_ffn_post, w_up, conv_w, conv_b, w_down):
    def trunk(x):
        for l in range(DEPTH):
            x = encoder_layer(x, g_mix_pre[l], g_mix_post[l], w_in[l], attn_rpb[l], ssm_lam_re[l],
                              ssm_lam_im[l], ssm_log_dt[l], ssm_b_re[l], ssm_b_im[l], ssm_c_re[l],
                              ssm_c_im[l], ssm_d[l], w_glu[l], b_glu[l], w_branch_att[l],
                              w_branch_ssm[l], w_out[l], g_ffn_pre[l], g_ffn_post[l], w_up[l],
                              conv_w[l], conv_b[l], w_down[l])
        return x

    y_prompt = trunk(x_prompt)
    y_sample = trunk(x_sample)
    return (y_prompt, y_sample)
```

```cpp
#include <hip/hip_runtime.h>
#include <hip/hip_cooperative_groups.h>
#include <cstdio>
#include <cstdint>
namespace cg = cooperative_groups;

#define LAS __attribute__((address_space(3)))
typedef unsigned short bf16_t;
typedef short bf16x8 __attribute__((ext_vector_type(8)));
typedef short bf16x4 __attribute__((ext_vector_type(4)));
typedef float f32x4 __attribute__((ext_vector_type(4)));
typedef float f32x2 __attribute__((ext_vector_type(2)));
typedef unsigned u32x4 __attribute__((ext_vector_type(4)));
typedef unsigned u32x2 __attribute__((ext_vector_type(2)));
typedef __bf16 bf2_t __attribute__((ext_vector_type(2)));

constexpr int M = 65536;
constexpr int MP = 32768;
constexpr int D = 1024, DATT = 512, DSSM = 512, NG = 32, DFF = 2816, NUP = 5632;
constexpr int TCH = 32, NCH = M / TCH, KS = 768;
constexpr float EPS = 1e-6f;

constexpr size_t MiB = 1u << 20;
constexpr size_t WS_CTL = 0;
constexpr size_t WS_WUP = 1 * MiB;
constexpr size_t WS_WDOWN = 12 * MiB;
constexpr size_t WS_ROWSQ1 = 17 * MiB + 512 * 1024;
constexpr size_t WS_ROWSQ2 = WS_ROWSQ1 + 256 * 1024;
constexpr size_t WS_CWT = 509 * MiB;
constexpr size_t WS_XB = 18 * MiB;
constexpr size_t WS_BIG = 146 * MiB;
constexpr size_t WS_WIN1 = WS_BIG;
constexpr size_t WS_WG = WS_WIN1 + 4 * MiB;
constexpr size_t WS_WGLU = WS_WG + 4 * MiB;
constexpr size_t WS_WBR = WS_WGLU + 512 * 1024;
constexpr size_t WS_WOUT = WS_WBR + 2 * MiB;
constexpr size_t WS_WSSM = WS_WOUT + 2 * MiB;
constexpr size_t WS_PSSM = WS_WSSM + 24 * MiB;
constexpr size_t WS_Q = 192 * MiB;
constexpr size_t WS_K = 256 * MiB;
constexpr size_t WS_VT = 320 * MiB;
constexpr size_t WS_AG = 384 * MiB;
constexpr size_t WS_T = 192 * MiB;
constexpr size_t WS_ACT = WS_BIG;
constexpr size_t WS_E = 498 * MiB;
constexpr size_t WS_END = 510 * MiB;
static_assert(WS_PSSM + 8 * MiB <= WS_Q, "ws map");
static_assert(WS_AG + 96 * MiB <= WS_E, "ws map");
static_assert(WS_E + (size_t)256 * 4 * NUP * 2 <= WS_CWT, "ws map");
constexpr size_t OUT_ATT = 0, OUT_L = 128 * MiB, OUT_Y = 192 * MiB;

constexpr int LDS_BYTES = 147456;
constexpr int LDS_X = 131072;

__device__ __forceinline__ unsigned pk2(float lo, float hi) { f32x2 v = {lo, hi}; bf2_t b = __builtin_convertvector(v, bf2_t); return __builtin_bit_cast(unsigned, b); }
__device__ __forceinline__ u32x2 pk4(f32x4 v) { u32x2 r; r.x = pk2(v[0], v[1]); r.y = pk2(v[2], v[3]); return r; }
__device__ __forceinline__ float bf2f(unsigned short b) { return __uint_as_float((unsigned)b << 16); }
__device__ __forceinline__ f32x4 unpk4(u32x2 w) { f32x4 r; r[0] = __uint_as_float(w.x << 16); r[1] = __uint_as_float(w.x & 0xffff0000u); r[2] = __uint_as_float(w.y << 16); r[3] = __uint_as_float(w.y & 0xffff0000u); return r; }
__device__ __forceinline__ float sigmoidf_(float x) { return __builtin_amdgcn_rcpf(1.0f + __expf(-x)); }
__device__ __forceinline__ float gelu_tanh(float x) { const float z = 1.5957691216057308f * (x + 0.044715f * x * x * x); return x * sigmoidf_(z); }
__device__ __forceinline__ float wave_sum(float v) {
#pragma unroll
    for (int o = 1; o < 64; o <<= 1) v += __shfl_xor(v, o);
    return v;
}
#define LDS_WAIT() asm volatile("s_waitcnt lgkmcnt(0)" ::: "memory")
template <int CTRL> __device__ __forceinline__ float dpp0(float x) { return __builtin_bit_cast(float, __builtin_amdgcn_update_dpp(0, __builtin_bit_cast(int, x), CTRL, 0xf, 0xf, true)); }
template <int CTRL> __device__ __forceinline__ f32x4 dpp4(f32x4 v) { f32x4 r; r[0] = dpp0<CTRL>(v[0]); r[1] = dpp0<CTRL>(v[1]); r[2] = dpp0<CTRL>(v[2]); r[3] = dpp0<CTRL>(v[3]); return r; }

namespace pg8 {
constexpr int BM = 256, BK = 64, HALF = 128, HTB = HALF * BK * 2, STAGE_BYTES = 8 * HTB, NXCD = 8, WGM = 8;
__host__ __device__ __forceinline__ int lds_byte(int r, int c) { const int st = (r >> 4) * 2 + (c >> 5), rr = r & 15, cc = c & 31, ob = rr * 64 + cc * 2; return st * 1024 + (ob ^ (((ob >> 9) & 1) << 5)); }
__host__ __device__ __forceinline__ void stage_rc(int b, int& R, int& C) { const int st = b / 1024, sb = b % 1024, swz = sb ^ (((sb >> 9) & 1) << 5); R = (st >> 1) * 16 + swz / 64; C = (st & 1) * 32 + (swz % 64) / 2; }

struct Unit { int pm, pn, pb; };
struct Gemm { const bf16_t* A; const bf16_t* Bt; };

template <int nM, int nN, int nB>
struct Order {
    static constexpr int nwg = nM * nN * nB;
    int G, c;
    __device__ void init(int G_, int c_) { G = G_; c = c_; }
    __device__ bool next(int i, Unit& u) const {
        const long L = (long)i * G + c; if (L >= nwg) return false;
        int wgid = (int)L; { constexpr int q = nwg / NXCD, r = nwg % NXCD; const int xcd = wgid % NXCD, off = wgid / NXCD; wgid = (xcd < r ? xcd * (q + 1) : r * (q + 1) + (xcd - r) * q) + off; }
        constexpr int per = nM * nN; u.pb = wgid / per; const int w = wgid % per;
        constexpr int nig = WGM * nN; const int gid = w / nig, fm = gid * WGM, gsz = (nM - fm) < WGM ? (nM - fm) : WGM;
        u.pm = fm + ((w % nig) % gsz); u.pn = (w % nig) / gsz; return true;
    }
};

template <int K, int LDA, int LDB, long SA, long SB, class Sched, class Epi>
__device__ __forceinline__ void gemm_phase(LAS unsigned char* lds, const Gemm g, const Sched& S, const Epi& E) {
    const int tid = threadIdx.x, wid = __builtin_amdgcn_readfirstlane(tid >> 6), lane = tid & 63, wr = wid >> 2, wc = wid & 3, fr = lane & 15, fq = lane >> 4;
    constexpr int nt = K / BK;
    unsigned voffA[2], voffB[2];
#pragma unroll
    for (int i = 0; i < 2; ++i) { int R, C; stage_rc(tid * 16 + i * 8192, R, C); voffA[i] = (unsigned)(R * LDA + C) * 2u; voffB[i] = (unsigned)(R * LDB + C) * 2u; }
    constexpr size_t kstep = (size_t)(BK * 2);
    constexpr size_t hstepA = (size_t)HALF * LDA * 2, hstepB = (size_t)HALF * LDB * 2;
    constexpr size_t tstepA = 2 * hstepA, tstepB = 2 * hstepB;
    const unsigned ldsw = (unsigned)wid * 1024u;
    const int aoff = lds_byte(wr * 64 + fr, fq * 8), boff = lds_byte(wc * 32 + fr, fq * 8);
#define PG8_SA(b, h) (((b) * 2 + (h)) * HTB)
#define PG8_SB(b, h) ((4 + (b) * 2 + (h)) * HTB)
#define PG8_STAGE(bufoff, gbase, voff) do { _Pragma("unroll") for (int _i = 0; _i < 2; ++_i) \
        __builtin_amdgcn_global_load_lds((const unsigned*)((const char*)(gbase) + (voff)[_i]), (LAS unsigned*)(lds + (bufoff) + ldsw + _i * 8192), 16, 0, 0); } while (0)
#define PG8_LDA(dst, b, h) do { _Pragma("unroll") for (int m = 0; m < 4; ++m) _Pragma("unroll") for (int k = 0; k < 2; ++k) dst[m][k] = *(const LAS bf16x8*)(lds + PG8_SA(b, h) + aoff + m * 2048 + k * 1024); } while (0)
#define PG8_LDB(dst, b, h) do { _Pragma("unroll") for (int n = 0; n < 2; ++n) _Pragma("unroll") for (int k = 0; k < 2; ++k) dst[n][k] = *(const LAS bf16x8*)(lds + PG8_SB(b, h) + boff + n * 2048 + k * 1024); } while (0)
#define PG8_MMA(ai, bj, At, Bt) do { __builtin_amdgcn_s_setprio(1); _Pragma("unroll") for (int m = 0; m < 4; ++m) _Pragma("unroll") for (int n = 0; n < 2; ++n) _Pragma("unroll") for (int k = 0; k < 2; ++k) \
        acc[ai][bj][m][n] = __builtin_amdgcn_mfma_f32_16x16x32_bf16(Bt[n][k], At[m][k], acc[ai][bj][m][n], 0, 0, 0); __builtin_amdgcn_s_setprio(0); } while (0)
#define PG8_WAIT_V(n) asm volatile("s_waitcnt vmcnt(" #n ")" ::: "memory")
#define PG8_WAIT_L(n) asm volatile("s_waitcnt lgkmcnt(" #n ")" ::: "memory")
#define PG8_BAR __builtin_amdgcn_s_barrier()
#define PG8_SCHED __builtin_amdgcn_sched_barrier(0)
    Unit cur, nxt; int ui = 0;
    if (!S.next(0, cur)) return;
    f32x4 acc[2][2][4][2];
#pragma unroll
    for (int a = 0; a < 2; ++a)
#pragma unroll
        for (int b = 0; b < 2; ++b)
#pragma unroll
            for (int m = 0; m < 4; ++m)
#pragma unroll
                for (int n = 0; n < 2; ++n) acc[a][b][m][n] = (f32x4){0.f, 0.f, 0.f, 0.f};
    bf16x8 At[4][2], B0[2][2], B1[2][2];
    const char* cA = (const char*)g.A + (size_t)cur.pb * (size_t)(SA * 2) + (size_t)cur.pm * tstepA;
    const char* cB = (const char*)g.Bt + (size_t)cur.pb * (size_t)(SB * 2) + (size_t)cur.pn * tstepB;
    PG8_STAGE(PG8_SB(0, 0), cB, voffB); PG8_STAGE(PG8_SB(0, 1), cB + hstepB, voffB); PG8_STAGE(PG8_SA(0, 0), cA, voffA); PG8_STAGE(PG8_SA(0, 1), cA + hstepA, voffA);
    if (wr == 1) PG8_BAR;
    PG8_WAIT_V(2); PG8_BAR;
    PG8_STAGE(PG8_SB(1, 0), cB + kstep, voffB); PG8_STAGE(PG8_SA(1, 0), cA + kstep, voffA); PG8_STAGE(PG8_SB(1, 1), cB + hstepB + kstep, voffB);
    PG8_WAIT_V(6); PG8_BAR;
    for (;;) {
        const bool has_next = S.next(ui + 1, nxt);
        const char* nA = has_next ? (const char*)g.A + (size_t)nxt.pb * (size_t)(SA * 2) + (size_t)nxt.pm * tstepA : cA;
        const char* nB = has_next ? (const char*)g.Bt + (size_t)nxt.pb * (size_t)(SB * 2) + (size_t)nxt.pn * tstepB : cB;
        for (int t = 0; t < nt; t += 2) {
            const bool last = (t == nt - 2);
            const char* a1 = cA + (size_t)(t + 1) * kstep;
            const char* a2 = last ? nA : cA + (size_t)(t + 2) * kstep; const char* b2 = last ? nB : cB + (size_t)(t + 2) * kstep;
            const char* a3 = a2 + kstep; const char* b3 = b2 + kstep;
            PG8_LDB(B0, 0, 0); PG8_LDB(B1, 0, 1); PG8_SCHED; PG8_LDA(At, 0, 0); PG8_STAGE(PG8_SA(1, 1), a1 + hstepA, voffA);
            PG8_WAIT_V(8); PG8_WAIT_L(0); PG8_BAR; PG8_MMA(0, 0, At, B0); PG8_MMA(0, 1, At, B1); PG8_BAR; PG8_SCHED;
            PG8_LDA(At, 0, 1); PG8_STAGE(PG8_SB(0, 0), b2, voffB); PG8_STAGE(PG8_SB(0, 1), b2 + hstepB, voffB); PG8_STAGE(PG8_SA(0, 0), a2, voffA);
            PG8_WAIT_V(8); PG8_WAIT_L(0); PG8_BAR; PG8_MMA(1, 0, At, B0); PG8_MMA(1, 1, At, B1); PG8_BAR; PG8_SCHED;
            PG8_LDB(B0, 1, 0); PG8_LDB(B1, 1, 1); PG8_SCHED; PG8_LDA(At, 1, 0); PG8_STAGE(PG8_SA(0, 1), a2 + hstepA, voffA);
            PG8_WAIT_V(8); PG8_WAIT_L(0); PG8_BAR; PG8_MMA(0, 0, At, B0); PG8_MMA(0, 1, At, B1); PG8_BAR; PG8_SCHED;
            PG8_LDA(At, 1, 1); PG8_STAGE(PG8_SB(1, 0), b3, voffB); PG8_STAGE(PG8_SB(1, 1), b3 + hstepB, voffB); PG8_STAGE(PG8_SA(1, 0), a3, voffA);
            PG8_WAIT_V(8); PG8_WAIT_L(0); PG8_BAR; PG8_MMA(1, 0, At, B0); PG8_MMA(1, 1, At, B1); PG8_BAR; PG8_SCHED;
        }
        if (wr == 0) PG8_BAR;
        E(acc, cur, wr, wc, fr, fq);
        if (!has_next) break;
#pragma unroll
        for (int a = 0; a < 2; ++a)
#pragma unroll
            for (int b = 0; b < 2; ++b)
#pragma unroll
                for (int m = 0; m < 4; ++m)
#pragma unroll
                    for (int n = 0; n < 2; ++n) acc[a][b][m][n] = (f32x4){0.f, 0.f, 0.f, 0.f};
        cur = nxt; cA = nA; cB = nB; ++ui;
        if (wr == 1) PG8_BAR;
    }
    PG8_WAIT_V(0);
    PG8_BAR;
#undef PG8_SA
#undef PG8_SB
#undef PG8_STAGE
#undef PG8_LDA
#undef PG8_LDB
#undef PG8_MMA
#undef PG8_WAIT_V
#undef PG8_WAIT_L
#undef PG8_BAR
#undef PG8_SCHED
}
}
using pg8::Unit;
typedef f32x4 Acc[2][2][4][2];

#define EPI_ROWS(...) _Pragma("unroll") for (int ai = 0; ai < 2; ++ai) _Pragma("unroll") for (int m = 0; m < 4; ++m) { const int row = u.pm * 256 + ai * 128 + wr * 64 + m * 16 + fr; __VA_ARGS__ }
#define EPI_COLS(...) _Pragma("unroll") for (int bj = 0; bj < 2; ++bj) _Pragma("unroll") for (int n = 0; n < 2; ++n) { const int col = u.pn * 256 + bj * 128 + wc * 32 + n * 16 + fq * 4; const f32x4 v = acc[ai][bj][m][n]; __VA_ARGS__ }

struct EpiQKVU {
    bf16_t *q, *k, *vt, *ag;
    __device__ __forceinline__ void operator()(const Acc& acc, const Unit& u, int wr, int wc, int fr, int fq) const {
        asm volatile("" : "+v"(fr), "+v"(fq));
        const int sel = u.pn >> 1;
        EPI_ROWS(
            const size_t tok = (size_t)row;
            EPI_COLS(
                if (sel == 0) { *(u32x2*)(q + tok * 512 + col) = pk4(v); }
                else if (sel == 1) { *(u32x2*)(k + tok * 512 + (col - 512)) = pk4(v); }
                else if (sel == 2) { const int d = col - 1024; const u32x2 w = pk4(v);
                    vt[(size_t)(d + 0) * M + tok] = (bf16_t)(w.x & 0xffffu); vt[(size_t)(d + 1) * M + tok] = (bf16_t)(w.x >> 16);
                    vt[(size_t)(d + 2) * M + tok] = (bf16_t)(w.y & 0xffffu); vt[(size_t)(d + 3) * M + tok] = (bf16_t)(w.y >> 16); }
                else { const int ch = col - 1536, gg = ch >> 4, hh = ch & 15; const int chunk = row >> 5, ii = row & 31;
                    *(u32x2*)(ag + ((size_t)gg * NCH + chunk) * KS + ii * 16 + hh) = pk4(v); }
            )
        )
    }
};
struct EpiLocal {
    float* L;
    __device__ __forceinline__ void operator()(const Acc& acc, const Unit& u, int wr, int wc, int fr, int fq) const {
        asm volatile("" : "+v"(fr), "+v"(fq));
        EPI_ROWS(
            EPI_COLS( *(f32x4*)(L + ((size_t)row * 32 + u.pb) * 256 + col) = v; )
        )
    }
};
struct EpiSsmOut {
    bf16_t* y;
    __device__ __forceinline__ void operator()(const Acc& acc, const Unit& u, int wr, int wc, int fr, int fq) const {
        asm volatile("" : "+v"(fr), "+v"(fq));
        EPI_ROWS(
            EPI_COLS(
                const int ii = col >> 4, hh = col & 15; const size_t tok = (size_t)row * 32 + ii;
                f32x4 o; o[0] = gelu_tanh(v[0]); o[1] = gelu_tanh(v[1]); o[2] = gelu_tanh(v[2]); o[3] = gelu_tanh(v[3]);
                *(u32x2*)(y + tok * 512 + u.pb * 16 + hh) = pk4(o);
            )
        )
    }
};
struct EpiGlu {
    const bf16_t* y; const float* bglu; bf16_t* o;
    __device__ __forceinline__ void operator()(const Acc& acc, const Unit& u, int wr, int wc, int fr, int fq) const {
        asm volatile("" : "+v"(fr), "+v"(fq));
        EPI_ROWS(
            EPI_COLS(
                const f32x4 yv = unpk4(*(const u32x2*)(y + (size_t)row * 512 + col)); const f32x4 bv = *(const f32x4*)(bglu + col);
                f32x4 r; r[0] = yv[0] * sigmoidf_(v[0] + bv[0]); r[1] = yv[1] * sigmoidf_(v[1] + bv[1]); r[2] = yv[2] * sigmoidf_(v[2] + bv[2]); r[3] = yv[3] * sigmoidf_(v[3] + bv[3]);
                *(u32x2*)(o + (size_t)row * 512 + col) = pk4(r);
            )
        )
    }
};
struct EpiT {
    bf16_t* T;
    __device__ __forceinline__ void operator()(const Acc& acc, const Unit& u, int wr, int wc, int fr, int fq) const {
        asm volatile("" : "+v"(fr), "+v"(fq));
        bf16_t* base = T + (size_t)u.pb * M * 1024;
        EPI_ROWS(
            EPI_COLS( *(u32x2*)(base + (size_t)row * 1024 + col) = pk4(v); )
        )
    }
};
struct EpiGate {
    bf16_t* T;
    __device__ __forceinline__ void operator()(const Acc& acc, const Unit& u, int wr, int wc, int fr, int fq) const {
        asm volatile("" : "+v"(fr), "+v"(fq));
        bf16_t* T1 = T; const bf16_t* T2 = T + (size_t)M * 1024;
        EPI_ROWS(
            _Pragma("unroll")
            for (int n = 0; n < 2; ++n) {
                const int c = u.pn * 128 + wc * 32 + n * 16 + fq * 4;
                const f32x4 ga = acc[ai][0][m][n], gs = acc[ai][1][m][n];
                const f32x4 t1 = unpk4(*(const u32x2*)(T1 + (size_t)row * 1024 + c)), t2 = unpk4(*(const u32x2*)(T2 + (size_t)row * 1024 + c));
                f32x4 r;
                _Pragma("unroll")
                for (int e = 0; e < 4; ++e) r[e] = sigmoidf_(ga[e]) * t1[e] + sigmoidf_(gs[e]) * t2[e];
                *(u32x2*)(T1 + (size_t)row * 1024 + c) = pk4(r);
            }
        )
    }
};
struct EpiOutF32 {
    float* y; float* rowsq;
    __device__ __forceinline__ void operator()(const Acc& acc, const Unit& u, int wr, int wc, int fr, int fq) const {
        asm volatile("" : "+v"(fr), "+v"(fq));
        EPI_ROWS(
            float s = 0.f;
            EPI_COLS( *(f32x4*)(y + (size_t)row * 1024 + col) = v; s += (v[0] * v[0] + v[1] * v[1]) + (v[2] * v[2] + v[3] * v[3]); )
            s += __shfl_xor(s, 16); s += __shfl_xor(s, 32);
            if (fq == 0) atomicAdd(rowsq + row, s);
        )
    }
};
struct EpiOutBf16 {
    bf16_t* y; float* rowsq;
    __device__ __forceinline__ void operator()(const Acc& acc, const Unit& u, int wr, int wc, int fr, int fq) const {
        asm volatile("" : "+v"(fr), "+v"(fq));
        EPI_ROWS(
            float s = 0.f;
            EPI_COLS( *(u32x2*)(y + (size_t)row * 1024 + col) = pk4(v); s += (v[0] * v[0] + v[1] * v[1]) + (v[2] * v[2] + v[3] * v[3]); )
            s += __shfl_xor(s, 16); s += __shfl_xor(s, 32);
            if (fq == 0) atomicAdd(rowsq + row, s);
        )
    }
};
#ifndef EPIUP_SB
#define EPIUP_SB
#endif
struct EpiUp {
    bf16_t* act; bf16_t* E; const float* cwt; LAS float* X;
    __device__ __forceinline__ void operator()(const Acc& acc, const Unit& u, int wr, int wc, int fr, int fq) const {
        asm volatile("" : "+v"(fr), "+v"(fq));
#pragma unroll
        for (int ai = 0; ai < 2; ++ai) {
            const int qrow = 2 * ai + wr;
#pragma unroll
            for (int bj = 0; bj < 2; ++bj)
#pragma unroll
                for (int n = 0; n < 2; ++n) {
                    const int cidx = bj * 128 + wc * 32 + n * 16 + fq * 4;
                    if (fr == 0) *(LAS f32x4*)(X + (2 * qrow + 0) * 256 + cidx) = acc[ai][bj][0][n];
                    if (fr == 15) *(LAS f32x4*)(X + (2 * qrow + 1) * 256 + cidx) = acc[ai][bj][3][n];
                    if (qrow == 0 && fr < 2) *(u32x2*)(E + ((size_t)u.pm * 4 + fr) * NUP + u.pn * 256 + cidx) = pk4(acc[ai][bj][0][n]);
                    if (qrow == 3 && fr >= 14) *(u32x2*)(E + ((size_t)u.pm * 4 + (fr - 12)) * NUP + u.pn * 256 + cidx) = pk4(acc[ai][bj][3][n]);
                }
        }
        asm volatile("s_waitcnt lgkmcnt(0)" ::: "memory"); __builtin_amdgcn_s_barrier(); asm volatile("" ::: "memory");
        const float first = fr == 0 ? 1.f : 0.f, lastf = fr == 15 ? 1.f : 0.f;
#pragma unroll
        for (int n = 0; n < 2; ++n) {
            const int ca = wc * 32 + n * 16 + fq * 4;
            const int j = u.pn * 128 + ca;
            const f32x4* wt = (const f32x4*)(cwt + (size_t)(j >> 2) * 32);
            const f32x4 wa0 = wt[0], wa1 = wt[1], wa2 = wt[2], ba = wt[3], wb0 = wt[4], wb1 = wt[5], wb2 = wt[6], bb = wt[7];
#pragma unroll
            for (int ai = 0; ai < 2; ++ai) {
                const int qrow = 2 * ai + wr;
                const int sp = qrow > 0 ? 2 * (qrow - 1) + 1 : 0, sn = qrow < 3 ? 2 * (qrow + 1) : 0;
                const float fp = qrow > 0 ? first : 0.f, fn = qrow < 3 ? lastf : 0.f;
#pragma unroll
                for (int m = 0; m < 4; ++m) {
                    const f32x4 a_c = acc[ai][0][m][n], b_c = acc[ai][1][m][n];
                    f32x4 a_p = dpp4<0x111>(a_c), b_p = dpp4<0x111>(b_c), a_n = dpp4<0x101>(a_c), b_n = dpp4<0x101>(b_c);
                    if (m > 0) { a_p += dpp4<0x10F>(acc[ai][0][m > 0 ? m - 1 : 0][n]); b_p += dpp4<0x10F>(acc[ai][1][m > 0 ? m - 1 : 0][n]); }
                    else { a_p += *(const LAS f32x4*)(X + sp * 256 + ca) * fp; b_p += *(const LAS f32x4*)(X + sp * 256 + 128 + ca) * fp; }
                    if (m < 3) { a_n += dpp4<0x11F>(acc[ai][0][m < 3 ? m + 1 : 3][n]); b_n += dpp4<0x11F>(acc[ai][1][m < 3 ? m + 1 : 3][n]); }
                    else { a_n += *(const LAS f32x4*)(X + sn * 256 + ca) * fn; b_n += *(const LAS f32x4*)(X + sn * 256 + 128 + ca) * fn; }
                    const int rt = ai * 128 + wr * 64 + m * 16 + fr;
                    f32x4 r;
#pragma unroll
                    for (int e = 0; e < 4; ++e) {
                        const float av = wa0[e] * a_p[e] + wa1[e] * a_c[e] + wa2[e] * a_n[e] + ba[e];
                        const float bv = wb0[e] * b_p[e] + wb1[e] * b_c[e] + wb2[e] * b_n[e] + bb[e];
                        r[e] = gelu_tanh(av) * bv;
                    }
                    if (rt != 0 && rt != 255) *(u32x2*)(act + ((size_t)u.pm * 256 + rt) * DFF + j) = pk4(r);
                    EPIUP_SB;
                }
            }
        }
    }
};

struct Params { const float* in[25]; float* out; unsigned char* ws; int ph_lo, ph_hi; };
enum { I_XP = 0, I_XS, I_GMPRE, I_GMPOST, I_WIN, I_RPB, I_LRE, I_LIM, I_LDT, I_BRE, I_BIM, I_CRE, I_CIM, I_SD, I_WGLU, I_BGLU, I_WBA, I_WBS, I_WOUT, I_GFPRE, I_GFPOST, I_WUP, I_CW, I_CB, I_WDOWN };

__device__ __forceinline__ const float* xrow_ptr(const Params& p, int tok) { return tok < MP ? p.in[I_XP] + (size_t)tok * D : p.in[I_XS] + (size_t)(tok - MP) * D; }

__device__ __forceinline__ void transpose_item(const float* W, int ldw, int K, int srccol0, bf16_t* WT, int destrow0, float scale, LAS float* scr, int kb, int lane) {
    const int k0 = 64 * kb;
#pragma unroll 8
    for (int i = 0; i < 32; ++i) { const int kk = 2 * i + (lane >> 5); scr[kk * 33 + (lane & 31)] = W[(size_t)(k0 + kk) * ldw + srccol0 + (lane & 31)]; }
    LDS_WAIT(); asm volatile("" ::: "memory");
    const int c = lane & 7;
#pragma unroll
    for (int j = 0; j < 4; ++j) { const int n = (lane >> 3) + 8 * j; const LAS float* s = scr + (8 * c) * 33 + n;
        u32x4 o; o.x = pk2(s[0 * 33] * scale, s[1 * 33] * scale); o.y = pk2(s[2 * 33] * scale, s[3 * 33] * scale); o.z = pk2(s[4 * 33] * scale, s[5 * 33] * scale); o.w = pk2(s[6 * 33] * scale, s[7 * 33] * scale);
        *(u32x4*)(WT + (size_t)(destrow0 + n) * K + k0 + 8 * c) = o; }
    LDS_WAIT(); asm volatile("" ::: "memory");
}

struct cplx { float x, y; };
__device__ __forceinline__ cplx cmul(cplx a, cplx b) { return {a.x * b.x - a.y * b.y, a.x * b.y + a.y * b.x}; }
__device__ __forceinline__ cplx cexp_scaled(float lre, float lim, float s) { const float mag = expf(lre * s); float sn, cs; sincosf(lim * s, &sn, &cs); return {mag * cs, mag * sn}; }
__device__ __forceinline__ cplx zoh_coef(float lre, float lim, float dt) {
    const cplx lb = cexp_scaled(lre, lim, dt); const float nx = lb.x - 1.0f, ny = lb.y; const float inv = 1.0f / (lre * lre + lim * lim);
    return {(nx * lre + ny * lim) * inv, (ny * lre - nx * lim) * inv};
}

__device__ __forceinline__ void phase0_prep(const Params& p, LAS unsigned char* lds, int tid, int lane, int wave) {
    unsigned char* ws = p.ws;
    const int G = gridDim.x, blk = blockIdx.x;
    const int gw = blk * 8 + wave, NGW = G * 8;
    const int gt = blk * 512 + tid, NGT = G * 512;
    { float* z = (float*)(ws + WS_ROWSQ1); for (int i = gt; i < 2 * M; i += NGT) z[i] = 0.f; }
    { float* t = (float*)(ws + WS_CWT); const float* cw = p.in[I_CW]; const float* cb = p.in[I_CB];
      for (int i = gt; i < (DFF / 4) * 32; i += NGT) { const int e = i & 3, k = (i >> 2) & 7, j = (i >> 5) * 4 + e; const int col = (k >= 4 ? DFF : 0) + j; const int kk = k & 3;
          t[i] = kk < 3 ? cw[kk * NUP + col] : cb[col]; } }
    {
        bf16_t* xb = (bf16_t*)(ws + WS_XB); const float* gp = p.in[I_GMPRE];
        f32x4 gv[4];
#pragma unroll
        for (int j = 0; j < 4; ++j) gv[j] = *(const f32x4*)(gp + 4 * (lane + 64 * j));
        for (int tok = gw; tok < M; tok += NGW) {
            const f32x4* xr = (const f32x4*)xrow_ptr(p, tok) + lane;
            f32x4 v[4]; float s = 0.f;
#pragma unroll
            for (int j = 0; j < 4; ++j) { v[j] = xr[64 * j]; s += (v[j][0] * v[j][0] + v[j][1] * v[j][1]) + (v[j][2] * v[j][2] + v[j][3] * v[j][3]); }
            const float rstd = rsqrtf(wave_sum(s) * (1.0f / D) + EPS);
            u32x2* o = (u32x2*)(xb + (size_t)tok * D) + lane;
#pragma unroll
            for (int j = 0; j < 4; ++j) { f32x4 r = v[j] * rstd * gv[j]; o[64 * j] = pk4(r); }
        }
    }
    {
        LAS float* scr = (LAS float*)(lds + wave * 16384);
        constexpr int I0 = 16 * 64;
        constexpr int I1 = 16 * 64;
        constexpr int I2 = 8 * 16;
        constexpr int I3 = 8 * 32;
        constexpr int I4 = 8 * 32;
        constexpr int I5 = 16 * 32;
        constexpr int I6 = 16 * 176;
        constexpr int I7 = 44 * 32;
        constexpr int NIT = I0 + I1 + I2 + I3 + I4 + I5 + I6 + I7;
        for (int it = gw; it < NIT; it += NGW) {
            int r = it;
            if (r < I0) { const int nb = r % 64, kb = r / 64, n0 = nb * 32; transpose_item(p.in[I_WIN], 4096, 1024, n0, (bf16_t*)(ws + WS_WIN1), n0, n0 < 512 ? 0.125f : 1.0f, scr, kb, lane); continue; } r -= I0;
            if (r < I1) { const int nb = r % 64, kb = r / 64, n0 = nb * 32; const int src = 2048 + ((n0 >> 7) & 1) * 1024 + (n0 >> 8) * 128 + (n0 & 127);
                          transpose_item(p.in[I_WIN], 4096, 1024, src, (bf16_t*)(ws + WS_WG), n0, 1.0f, scr, kb, lane); continue; } r -= I1;
            if (r < I2) { const int nb = r % 16, kb = r / 16, n0 = nb * 32; transpose_item(p.in[I_WGLU], 512, 512, n0, (bf16_t*)(ws + WS_WGLU), n0, 1.0f, scr, kb, lane); continue; } r -= I2;
            if (r < I3) { const int nb = r % 32, kb = r / 32, n0 = nb * 32; transpose_item(p.in[I_WBA], 1024, 512, n0, (bf16_t*)(ws + WS_WBR), n0, 1.0f, scr, kb, lane); continue; } r -= I3;
            if (r < I4) { const int nb = r % 32, kb = r / 32, n0 = nb * 32; transpose_item(p.in[I_WBS], 1024, 512, n0, (bf16_t*)(ws + WS_WBR) + (size_t)1024 * 512, n0, 1.0f, scr, kb, lane); continue; } r -= I4;
            if (r < I5) { const int nb = r % 32, kb = r / 32, n0 = nb * 32; transpose_item(p.in[I_WOUT], 1024, 1024, n0, (bf16_t*)(ws + WS_WOUT), n0, 1.0f, scr, kb, lane); continue; } r -= I5;
            if (r < I6) { const int nb = r % 176, kb = r / 176, n0 = nb * 32; const int src = ((n0 >> 7) & 1) * DFF + (n0 >> 8) * 128 + (n0 & 127);
                          transpose_item(p.in[I_WUP], NUP, 1024, src, (bf16_t*)(ws + WS_WUP), n0, 1.0f, scr, kb, lane); continue; } r -= I6;
            { const int nb = r % 32, kb = r / 32, n0 = nb * 32; transpose_item(p.in[I_WDOWN], 1024, DFF, n0, (bf16_t*)(ws + WS_WDOWN), n0, 1.0f, scr, kb, lane); }
        }
    }
    __syncthreads();
    const float* lre = p.in[I_LRE]; const float* lim = p.in[I_LIM]; const float* ldt = p.in[I_LDT];
    const float* bre = p.in[I_BRE]; const float* bim = p.in[I_BIM]; const float* cre = p.in[I_CRE]; const float* cim = p.in[I_CIM];
    bf16_t* Wssm = (bf16_t*)(ws + WS_WSSM); bf16_t* Pssm = (bf16_t*)(ws + WS_PSSM);
    {
        LAS float* Fs = (LAS float*)lds;
        for (int it = blk; it < NG * 63; it += G) {
            const int g = it / 63, d = it % 63 - 31, e = d < 0 ? -d : d;
            __syncthreads();
            if (tid < 128) {
                const int dir = tid >> 6, pp = tid & 63; const bool use = dir == 0 ? (d >= 0) : (d <= 0);
                const float a = lre[(dir * NG + g) * 64 + pp], b = lim[(dir * NG + g) * 64 + pp], dt = expf(ldt[dir * NG + g]);
                cplx F = cmul(cexp_scaled(a, b, dt * (float)e), zoh_coef(a, b, dt));
                if (!use) { F.x = 0.f; F.y = 0.f; }
                Fs[(dir * 64 + pp) * 2 + 0] = F.x; Fs[(dir * 64 + pp) * 2 + 1] = F.y;
            }
            __syncthreads();
            if (tid < 256) {
                const int h = tid >> 4, hp = tid & 15; float accv = 0.f;
                for (int dir = 0; dir < 2; ++dir)
                    for (int pp = 0; pp < 64; ++pp) {
                        const cplx c = {cre[((dir * NG + g) * 16 + h) * 64 + pp], cim[((dir * NG + g) * 16 + h) * 64 + pp]};
                        const cplx bq = {bre[((dir * NG + g) * 64 + pp) * 16 + hp], bim[((dir * NG + g) * 64 + pp) * 16 + hp]};
                        const cplx F = {Fs[(dir * 64 + pp) * 2 + 0], Fs[(dir * 64 + pp) * 2 + 1]};
                        const cplx cf = cmul(c, F);
                        accv += cf.x * bq.x - cf.y * bq.y;
                    }
                if (d == 0 && h == hp) accv += p.in[I_SD][16 * g + h];
                const bf16_t w = (bf16_t)(pk2(accv, 0.f) & 0xffffu);
                const int i0 = d > 0 ? d : 0, i1 = d < 0 ? 31 + d : 31;
                for (int i = i0; i <= i1; ++i) { const int s = i - d; Wssm[((size_t)g * 512 + i * 16 + h) * KS + s * 16 + hp] = w; }
            }
        }
        __syncthreads();
    }
    for (int idx = gt; idx < NG * 32 * 16 * 2 * 64; idx += NGT) {
        const int pp = idx & 63, dir = (idx >> 6) & 1, h = (idx >> 7) & 15, i = (idx >> 11) & 31, g = idx >> 16;
        const float a = lre[(dir * NG + g) * 64 + pp], b = lim[(dir * NG + g) * 64 + pp], dt = expf(ldt[dir * NG + g]);
        const int e = dir == 0 ? i + 1 : 32 - i;
        const cplx c = {cre[((dir * NG + g) * 16 + h) * 64 + pp], cim[((dir * NG + g) * 16 + h) * 64 + pp]};
        const cplx cl = cmul(c, cexp_scaled(a, b, dt * (float)e));
        bf16_t* dst = Wssm + ((size_t)g * 512 + i * 16 + h) * KS + 512 + dir * 128 + pp;
        dst[0] = (bf16_t)(pk2(cl.x, 0.f) & 0xffffu); dst[64] = (bf16_t)(pk2(-cl.y, 0.f) & 0xffffu);
    }
    for (int idx = gt; idx < NG * 2 * 64 * 32 * 16; idx += NGT) {
        const int hp = idx & 15, s = (idx >> 4) & 31, pp = (idx >> 9) & 63, dir = (idx >> 15) & 1, g = idx >> 16;
        const float a = lre[(dir * NG + g) * 64 + pp], b = lim[(dir * NG + g) * 64 + pp], dt = expf(ldt[dir * NG + g]);
        const int e = dir == 0 ? 31 - s : s;
        const cplx bq = {bre[((dir * NG + g) * 64 + pp) * 16 + hp], bim[((dir * NG + g) * 64 + pp) * 16 + hp]};
        const cplx v = cmul(cmul(cexp_scaled(a, b, dt * (float)e), zoh_coef(a, b, dt)), bq);
        bf16_t* dst = Pssm + ((size_t)g * 256 + dir * 128 + pp) * 512 + s * 16 + hp;
        dst[0] = (bf16_t)(pk2(v.x, 0.f) & 0xffffu); dst[(size_t)64 * 512] = (bf16_t)(pk2(v.y, 0.f) & 0xffffu);
    }
}

__device__ __forceinline__ void attn_phase(const bf16_t* __restrict__ qb, const bf16_t* __restrict__ kb, const bf16_t* __restrict__ vt, bf16_t* __restrict__ att, const float* __restrict__ rpb, int wave, int lane) {
    const int G = gridDim.x, blk = blockIdx.x;
    const int per = (4096 + G - 1) / G;
    const int qi = lane & 15, q4 = lane >> 4, n = wave & 3, hsel = wave >> 2;
    const int c = 16 * n + qi;
    int cs = c - 8; cs = cs < 0 ? 0 : (cs > 48 ? 48 : cs);
    int bs = 16 * n - 8; bs = bs < 0 ? 0 : (bs > 32 ? 32 : bs);
    for (int ui = 0; ui < per; ++ui) {
        const int u = blk * per + ui; if (u >= 4096) break;
        const int hp = u >> 10, R = u & 1023, h = hp * 2 + hsel;
        int r, rows; if (R < 512) { r = R & 63; rows = 64; } else { r = (R - 512) & 31; rows = 32; }
        const int Rbase = R - r; int rs = r - 4; rs = rs < 0 ? 0 : (rs > rows - 8 ? rows - 8 : rs);
        const size_t tokq = (size_t)R * 64 + c;
        bf16x8 qf[2];
        qf[0] = *(const bf16x8*)(qb + tokq * 512 + h * 64 + q4 * 8);
        qf[1] = *(const bf16x8*)(qb + tokq * 512 + h * 64 + 32 + q4 * 8);
        f32x4 st[8][2];
#pragma unroll
        for (int kr = 0; kr < 8; ++kr)
#pragma unroll
            for (int hf = 0; hf < 2; ++hf) {
                const size_t ktok = (size_t)(Rbase + rs + kr) * 64 + bs + 16 * hf + qi;
                const bf16x8 k0 = *(const bf16x8*)(kb + ktok * 512 + h * 64 + q4 * 8);
                const bf16x8 k1 = *(const bf16x8*)(kb + ktok * 512 + h * 64 + 32 + q4 * 8);
                f32x4 a = {0.f, 0.f, 0.f, 0.f};
                a = __builtin_amdgcn_mfma_f32_16x16x32_bf16(k0, qf[0], a, 0, 0, 0);
                a = __builtin_amdgcn_mfma_f32_16x16x32_bf16(k1, qf[1], a, 0, 0, 0);
                st[kr][hf] = a;
            }
        float mx = -1e30f;
#pragma unroll
        for (int kr = 0; kr < 8; ++kr) {
            const float* brow = rpb + (h * 15 + (rs + kr - r + 7)) * 31;
#pragma unroll
            for (int hf = 0; hf < 2; ++hf)
#pragma unroll
                for (int e = 0; e < 4; ++e) {
                    const int kc = bs + 16 * hf + 4 * q4 + e; const bool valid = (kc >= cs) && (kc < cs + 16);
                    int dc = kc - c + 15; dc = dc < 0 ? 0 : (dc > 30 ? 30 : dc);
                    const float s = valid ? st[kr][hf][e] + brow[dc] : -1e30f;
                    st[kr][hf][e] = s; mx = fmaxf(mx, s);
                }
        }
        mx = fmaxf(mx, __shfl_xor(mx, 16)); mx = fmaxf(mx, __shfl_xor(mx, 32));
        float l = 0.f;
#pragma unroll
        for (int kr = 0; kr < 8; ++kr)
#pragma unroll
            for (int hf = 0; hf < 2; ++hf)
#pragma unroll
                for (int e = 0; e < 4; ++e) { const float pv = __expf(st[kr][hf][e] - mx); st[kr][hf][e] = pv; l += pv; }
        l += __shfl_xor(l, 16); l += __shfl_xor(l, 32);
        f32x4 o[4];
#pragma unroll
        for (int dt = 0; dt < 4; ++dt) o[dt] = (f32x4){0.f, 0.f, 0.f, 0.f};
#pragma unroll
        for (int kr = 0; kr < 8; ++kr) {
            u32x4 pw; pw.x = pk2(st[kr][0][0], st[kr][0][1]); pw.y = pk2(st[kr][0][2], st[kr][0][3]); pw.z = pk2(st[kr][1][0], st[kr][1][1]); pw.w = pk2(st[kr][1][2], st[kr][1][3]);
            const bf16x8 pf = __builtin_bit_cast(bf16x8, pw);
            const size_t tok0 = (size_t)(Rbase + rs + kr) * 64 + bs + 4 * q4;
#pragma unroll
            for (int dt = 0; dt < 4; ++dt) {
                const bf16_t* vrow = vt + (size_t)(h * 64 + dt * 16 + qi) * M + tok0;
                const u32x2 v0 = *(const u32x2*)(vrow), v1 = *(const u32x2*)(vrow + 16);
                u32x4 vw; vw.x = v0.x; vw.y = v0.y; vw.z = v1.x; vw.w = v1.y;
                o[dt] = __builtin_amdgcn_mfma_f32_16x16x32_bf16(__builtin_bit_cast(bf16x8, vw), pf, o[dt], 0, 0, 0);
            }
        }
        const float inv = 1.0f / l;
#pragma unroll
        for (int dt = 0; dt < 4; ++dt) { f32x4 r = o[dt] * inv; *(u32x2*)(att + tokq * 512 + h * 64 + dt * 16 + 4 * q4) = pk4(r); }
    }
}

__device__ __forceinline__ void scan_phase(const Params& p, const float* __restrict__ Lb, bf16_t* __restrict__ ag, int tid) {
    const int gt = blockIdx.x * 512 + tid, NGT = gridDim.x * 512;
    for (int idx = gt; idx < 24 * NG * 2 * 64; idx += NGT) {
        const int pp = idx & 63, dir = (idx >> 6) & 1, g = (idx >> 7) & 31, seq = idx >> 12;
        const int nch = seq < 8 ? 128 : 64, ch0 = seq < 8 ? seq * 128 : 1024 + (seq - 8) * 64;
        const float a = p.in[I_LRE][(dir * NG + g) * 64 + pp], b = p.in[I_LIM][(dir * NG + g) * 64 + pp], dt = expf(p.in[I_LDT][dir * NG + g]);
        const cplx lt = cexp_scaled(a, b, dt * (float)TCH);
        float hx = 0.f, hy = 0.f;
        const int colr = dir * 128 + pp;
        for (int c0 = 0; c0 < nch; c0 += 8) {
            float lr[8], li[8];
#pragma unroll
            for (int j = 0; j < 8; ++j) { const int cc = dir == 0 ? c0 + j : nch - 1 - (c0 + j); const float* src = Lb + ((size_t)(ch0 + cc) * 32 + g) * 256 + colr; lr[j] = src[0]; li[j] = src[64]; }
#pragma unroll
            for (int j = 0; j < 8; ++j) {
                const int cc = dir == 0 ? c0 + j : nch - 1 - (c0 + j);
                bf16_t* dst = ag + ((size_t)g * NCH + ch0 + cc) * KS + 512 + colr;
                dst[0] = (bf16_t)(pk2(hx, 0.f) & 0xffffu); dst[64] = (bf16_t)(pk2(hy, 0.f) & 0xffffu);
                const float nx = lt.x * hx - lt.y * hy + lr[j], ny = lt.x * hy + lt.y * hx + li[j];
                hx = nx; hy = ny;
            }
        }
    }
}

__device__ __forceinline__ void norm_phase(const Params& p, int lane, int wave) {
    const int gw = blockIdx.x * 8 + wave, NGW = gridDim.x * 8;
    const float* rowsq1 = (const float*)(p.ws + WS_ROWSQ1); bf16_t* xb = (bf16_t*)(p.ws + WS_XB);
    f32x4 g1[4], g2[4];
#pragma unroll
    for (int j = 0; j < 4; ++j) { g1[j] = *(const f32x4*)(p.in[I_GMPOST] + 4 * (lane + 64 * j)); g2[j] = *(const f32x4*)(p.in[I_GFPRE] + 4 * (lane + 64 * j)); }
    for (int tok = gw; tok < M; tok += NGW) {
        const f32x4* xr = (const f32x4*)xrow_ptr(p, tok) + lane; f32x4* yr = (f32x4*)(p.out + (size_t)tok * D) + lane;
        const float rstd1 = rsqrtf(rowsq1[tok] * (1.0f / D) + EPS);
        f32x4 v[4]; float s = 0.f;
#pragma unroll
        for (int j = 0; j < 4; ++j) { v[j] = xr[64 * j] + yr[64 * j] * rstd1 * g1[j]; s += (v[j][0] * v[j][0] + v[j][1] * v[j][1]) + (v[j][2] * v[j][2] + v[j][3] * v[j][3]); }
        const float rstd2 = rsqrtf(wave_sum(s) * (1.0f / D) + EPS);
        u32x2* o = (u32x2*)(xb + (size_t)tok * D) + lane;
#pragma unroll
        for (int j = 0; j < 4; ++j) { yr[64 * j] = v[j]; f32x4 r = v[j] * rstd2 * g2[j]; o[64 * j] = pk4(r); }
    }
}
__device__ __forceinline__ void fixup_phase(const Params& p, int tid) {
    const int gt = blockIdx.x * 512 + tid, NGT = gridDim.x * 512;
    const bf16_t* E = (const bf16_t*)(p.ws + WS_E); bf16_t* act = (bf16_t*)(p.ws + WS_ACT); const float* cw = p.in[I_CW]; const float* cb = p.in[I_CB];
    for (int idx = gt; idx < 256 * 2 * (DFF / 4); idx += NGT) {
        const int j = (idx % (DFF / 4)) * 4, which = (idx / (DFF / 4)) & 1, pm = idx / (2 * (DFF / 4));
        const bool seq_first = pm < 128 ? (pm % 16 == 0) : ((pm - 128) % 8 == 0), seq_last = pm < 128 ? (pm % 16 == 15) : ((pm - 128) % 8 == 7);
        const int ec = (j >> 7) * 256 + (j & 127);
        const f32x4 z4 = {0.f, 0.f, 0.f, 0.f};
        f32x4 ap, ac, an, bp, bc, bn;
        auto ld = [&](int tile, int slot, int coff) { return unpk4(*(const u32x2*)(E + ((size_t)tile * 4 + slot) * NUP + ec + coff)); };
        if (which == 0) { ac = ld(pm, 0, 0); bc = ld(pm, 0, 128); an = ld(pm, 1, 0); bn = ld(pm, 1, 128);
            if (seq_first) { ap = z4; bp = z4; } else { ap = ld(pm - 1, 3, 0); bp = ld(pm - 1, 3, 128); } }
        else { ap = ld(pm, 2, 0); bp = ld(pm, 2, 128); ac = ld(pm, 3, 0); bc = ld(pm, 3, 128);
            if (seq_last) { an = z4; bn = z4; } else { an = ld(pm + 1, 0, 0); bn = ld(pm + 1, 0, 128); } }
        const f32x4 wa0 = *(const f32x4*)(cw + j), wa1 = *(const f32x4*)(cw + NUP + j), wa2 = *(const f32x4*)(cw + 2 * NUP + j), ba = *(const f32x4*)(cb + j);
        const f32x4 wb0 = *(const f32x4*)(cw + DFF + j), wb1 = *(const f32x4*)(cw + NUP + DFF + j), wb2 = *(const f32x4*)(cw + 2 * NUP + DFF + j), bb = *(const f32x4*)(cb + DFF + j);
        f32x4 r;
#pragma unroll
        for (int e = 0; e < 4; ++e) {
            const float av = wa0[e] * ap[e] + wa1[e] * ac[e] + wa2[e] * an[e] + ba[e];
            const float bv = wb0[e] * bp[e] + wb1[e] * bc[e] + wb2[e] * bn[e] + bb[e];
            r[e] = gelu_tanh(av) * bv;
        }
        const size_t tok = (size_t)pm * 256 + (which ? 255 : 0);
        *(u32x2*)(act + tok * DFF + j) = pk4(r);
    }
}
__device__ __forceinline__ void final_phase(const Params& p, int lane, int wave) {
    const int gw = blockIdx.x * 8 + wave, NGW = gridDim.x * 8;
    const float* rowsq2 = (const float*)(p.ws + WS_ROWSQ2); const bf16_t* y2 = (const bf16_t*)(p.ws + WS_XB);
    f32x4 g[4];
#pragma unroll
    for (int j = 0; j < 4; ++j) g[j] = *(const f32x4*)(p.in[I_GFPOST] + 4 * (lane + 64 * j));
    for (int tok = gw; tok < M; tok += NGW) {
        f32x4* orow = (f32x4*)(p.out + (size_t)tok * D) + lane; const u32x2* yr = (const u32x2*)(y2 + (size_t)tok * D) + lane;
        const float rstd = rsqrtf(rowsq2[tok] * (1.0f / D) + EPS);
#pragma unroll
        for (int j = 0; j < 4; ++j) { const f32x4 yv = unpk4(yr[64 * j]); orow[64 * j] = orow[64 * j] + yv * rstd * g[j]; }
    }
}

constexpr int NPHASE = 14;
#ifndef PHMASK
#define PHMASK 0x3fff
#endif
typedef const __attribute__((address_space(4))) Params* KArgs;
__device__ __forceinline__ Params load_params(KArgs q) { Params p;
#pragma unroll
    for (int i = 0; i < 25; ++i) p.in[i] = q->in[i];
    p.out = q->out; p.ws = q->ws; p.ph_lo = q->ph_lo; p.ph_hi = q->ph_hi; return p; }
#define PHASE_ARGS() KArgs q_ = kp; asm volatile("" : "+s"(q_)); const Params p = load_params(q_); unsigned char* ws = p.ws; unsigned char* ob = (unsigned char*)p.out; bf16_t* xb = (bf16_t*)(ws + WS_XB); (void)ob; (void)xb
__global__ void __launch_bounds__(512, 2) fwd_kernel(Params parg) {
    extern __shared__ __attribute__((aligned(16))) unsigned char lds_raw[];
    LAS unsigned char* lds = (LAS unsigned char*)lds_raw;
    const int tid = threadIdx.x, lane = tid & 63, wave = __builtin_amdgcn_readfirstlane(tid >> 6);
    const int G = gridDim.x, blk = blockIdx.x;
    KArgs kp = (KArgs)__builtin_amdgcn_kernarg_segment_ptr();
    const int ph_lo = kp->ph_lo, ph_hi = kp->ph_hi;
    cg::grid_group grid = cg::this_grid();
#define IN(k) (((PHMASK >> (k)) & 1) && ph_lo <= (k) && (k) < ph_hi)
#define SEAM(k) do { if (ph_lo <= (k) && (k) + 1 < ph_hi) grid.sync(); } while (0)

    if (IN(0)) { PHASE_ARGS(); phase0_prep(p, lds, tid, lane, wave); } SEAM(0);
    if (IN(1)) { PHASE_ARGS();
        pg8::Gemm g{xb, (const bf16_t*)(ws + WS_WIN1)}; pg8::Order<M / 256, 8, 1> S; S.init(G, blk);
        EpiQKVU E{(bf16_t*)(ws + WS_Q), (bf16_t*)(ws + WS_K), (bf16_t*)(ws + WS_VT), (bf16_t*)(ws + WS_AG)};
        pg8::gemm_phase<1024, 1024, 1024, 0, 0>(lds, g, S, E);
    } SEAM(1);
    if (IN(2)) { PHASE_ARGS();
        attn_phase((const bf16_t*)(ws + WS_Q), (const bf16_t*)(ws + WS_K), (const bf16_t*)(ws + WS_VT), (bf16_t*)(ob + OUT_ATT), p.in[I_RPB], wave, lane);
        __syncthreads();
        pg8::Gemm g{(const bf16_t*)(ws + WS_AG), (const bf16_t*)(ws + WS_PSSM)}; pg8::Order<NCH / 256, 1, NG> S; S.init(G, blk);
        EpiLocal E{(float*)(ob + OUT_L)};
        pg8::gemm_phase<512, KS, 512, (long)NCH * KS, 256L * 512>(lds, g, S, E);
    } SEAM(2);
    if (IN(3)) { PHASE_ARGS(); scan_phase(p, (const float*)(ob + OUT_L), (bf16_t*)(ws + WS_AG), tid); } SEAM(3);
    if (IN(4)) { PHASE_ARGS();
        pg8::Gemm g{(const bf16_t*)(ws + WS_AG), (const bf16_t*)(ws + WS_WSSM)}; pg8::Order<NCH / 256, 2, NG> S; S.init(G, blk);
        EpiSsmOut E{(bf16_t*)(ob + OUT_Y)};
        pg8::gemm_phase<KS, KS, KS, (long)NCH * KS, 512L * KS>(lds, g, S, E);
    } SEAM(4);
    if (IN(5)) { PHASE_ARGS();
        pg8::Gemm g{(const bf16_t*)(ob + OUT_Y), (const bf16_t*)(ws + WS_WGLU)}; pg8::Order<M / 256, 2, 1> S; S.init(G, blk);
        EpiGlu E{(const bf16_t*)(ob + OUT_Y), p.in[I_BGLU], (bf16_t*)(ob + OUT_ATT) + (size_t)M * 512};
        pg8::gemm_phase<512, 512, 512, 0, 0>(lds, g, S, E);
    } SEAM(5);
    if (IN(6)) { PHASE_ARGS();
        pg8::Gemm g{(const bf16_t*)(ob + OUT_ATT), (const bf16_t*)(ws + WS_WBR)}; pg8::Order<M / 256, 4, 2> S; S.init(G, blk);
        EpiT E{(bf16_t*)(ws + WS_T)};
        pg8::gemm_phase<512, 512, 512, (long)M * 512, 1024L * 512>(lds, g, S, E);
    } SEAM(6);
    if (IN(7)) { PHASE_ARGS();
        pg8::Gemm g{xb, (const bf16_t*)(ws + WS_WG)}; pg8::Order<M / 256, 8, 1> S; S.init(G, blk);
        EpiGate E{(bf16_t*)(ws + WS_T)};
        pg8::gemm_phase<1024, 1024, 1024, 0, 0>(lds, g, S, E);
    } SEAM(7);
    if (IN(8)) { PHASE_ARGS();
        pg8::Gemm g{(const bf16_t*)(ws + WS_T), (const bf16_t*)(ws + WS_WOUT)}; pg8::Order<M / 256, 4, 1> S; S.init(G, blk);
        EpiOutF32 E{p.out, (float*)(ws + WS_ROWSQ1)};
        pg8::gemm_phase<1024, 1024, 1024, 0, 0>(lds, g, S, E);
    } SEAM(8);
    if (IN(9)) { PHASE_ARGS(); norm_phase(p, lane, wave); } SEAM(9);
    if (IN(10)) { PHASE_ARGS();
        pg8::Gemm g{xb, (const bf16_t*)(ws + WS_WUP)}; pg8::Order<M / 256, NUP / 256, 1> S; S.init(G, blk);
        EpiUp E{(bf16_t*)(ws + WS_ACT), (bf16_t*)(ws + WS_E), (const float*)(ws + WS_CWT), (LAS float*)(lds + LDS_X)};
        pg8::gemm_phase<1024, 1024, 1024, 0, 0>(lds, g, S, E);
    } SEAM(10);
    if (IN(11)) { PHASE_ARGS(); fixup_phase(p, tid); } SEAM(11);
    if (IN(12)) { PHASE_ARGS();
        pg8::Gemm g{(const bf16_t*)(ws + WS_ACT), (const bf16_t*)(ws + WS_WDOWN)}; pg8::Order<M / 256, 4, 1> S; S.init(G, blk);
        EpiOutBf16 E{xb, (float*)(ws + WS_ROWSQ2)};
        pg8::gemm_phase<DFF, DFF, DFF, 0, 0>(lds, g, S, E);
    } SEAM(12);
    if (IN(13)) { PHASE_ARGS(); final_phase(p, lane, wave); }
#undef IN
#undef SEAM
}

#ifndef N_LAUNCHES
#define N_LAUNCHES 1
#endif
extern "C" void kernel_launch(void* const* d_in, const int* in_sizes, int n_in, void* d_out, int out_size, void* d_ws, size_t ws_size, hipStream_t stream) {
    static int grid = 0;
    if (grid == 0) {
        if (n_in != 25 || out_size != M * D || ws_size < WS_END) { fprintf(stderr, "kernel_launch: unexpected shapes (n_in %d out %d ws %zu)\n", n_in, out_size, ws_size); grid = -1; return; }
        int dev = 0, cus = 0, per_cu = 0;
        hipGetDevice(&dev); hipDeviceGetAttribute(&cus, hipDeviceAttributeMultiprocessorCount, dev);
        hipFuncSetAttribute((const void*)fwd_kernel, hipFuncAttributeMaxDynamicSharedMemorySize, LDS_BYTES);
        hipOccupancyMaxActiveBlocksPerMultiprocessor(&per_cu, (const void*)fwd_kernel, 512, LDS_BYTES);
        (void)hipGetLastError();
        if (per_cu < 1) { fprintf(stderr, "kernel_launch: occupancy query says %d blocks per CU\n", per_cu); per_cu = 1; }
        grid = cus;
    }
    if (grid < 0) return;
    Params p{};
    for (int i = 0; i < 25; ++i) p.in[i] = (const float*)d_in[i];
    p.out = (float*)d_out; p.ws = (unsigned char*)d_ws;
    if (N_LAUNCHES == 1) {
        p.ph_lo = 0; p.ph_hi = NPHASE;
        void* args[] = {&p};
        hipError_t e = hipLaunchCooperativeKernel((const void*)fwd_kernel, dim3(grid), dim3(512), args, LDS_BYTES, stream);
        if (e != hipSuccess) fprintf(stderr, "cooperative launch failed: %s (grid %d)\n", hipGetErrorString(e), grid);
    } else {
        for (int k = 0; k < NPHASE; ++k) {
            p.ph_lo = k; p.ph_hi = k + 1;
            hipLaunchKernelGGL(fwd_kernel, dim3(grid), dim3(512), LDS_BYTES, stream, p);
        }
    }
}
```

```cpp
#include <hip/hip_runtime.h>
#include <hip/hip_cooperative_groups.h>
#include <cstdio>
#include <cstdint>
namespace cg = cooperative_groups;

#define LAS __attribute__((address_space(3)))
typedef unsigned short bf16_t;
typedef short bf16x8 __attribute__((ext_vector_type(8)));
typedef short bf16x4 __attribute__((ext_vector_type(4)));
typedef float f32x4 __attribute__((ext_vector_type(4)));
typedef float f32x2 __attribute__((ext_vector_type(2)));
typedef unsigned u32x4 __attribute__((ext_vector_type(4)));
typedef unsigned u32x2 __attribute__((ext_vector_type(2)));
typedef __bf16 bf2_t __attribute__((ext_vector_type(2)));

constexpr int M = 65536;
constexpr int MP = 32768;
constexpr int D = 1024, DATT = 512, DSSM = 512, NG = 32, DFF = 2816, NUP = 5632;
constexpr int TCH = 32, NCH = M / TCH, KS = 768;
constexpr float EPS = 1e-6f;

constexpr size_t MiB = 1u << 20;
constexpr size_t WS_CTL = 0;
constexpr size_t WS_WUP = 1 * MiB;
constexpr size_t WS_WDOWN = 12 * MiB;
constexpr size_t WS_ROWSQ1 = 17 * MiB + 512 * 1024;
constexpr size_t WS_ROWSQ2 = WS_ROWSQ1 + 256 * 1024;
constexpr size_t WS_CWT = 509 * MiB;
constexpr size_t WS_XB = 18 * MiB;
constexpr size_t WS_BIG = 146 * MiB;
constexpr size_t WS_WIN1 = WS_BIG;
constexpr size_t WS_WG = WS_WIN1 + 4 * MiB;
constexpr size_t WS_WGLU = WS_WG + 4 * MiB;
constexpr size_t WS_WBR = WS_WGLU + 512 * 1024;
constexpr size_t WS_WOUT = WS_WBR + 2 * MiB;
constexpr size_t WS_WSSM = WS_WOUT + 2 * MiB;
constexpr size_t WS_PSSM = WS_WSSM + 24 * MiB;
constexpr size_t WS_Q = 192 * MiB;
constexpr size_t WS_K = 256 * MiB;
constexpr size_t WS_VT = 320 * MiB;
constexpr size_t WS_AG = 384 * MiB;
constexpr size_t WS_T = 192 * MiB;
constexpr size_t WS_ACT = WS_BIG;
constexpr size_t WS_E = 498 * MiB;
constexpr size_t WS_END = 510 * MiB;
static_assert(WS_PSSM + 8 * MiB <= WS_Q, "ws map");
static_assert(WS_AG + 96 * MiB <= WS_E, "ws map");
static_assert(WS_E + (size_t)256 * 4 * NUP * 2 <= WS_CWT, "ws map");
constexpr size_t OUT_ATT = 0, OUT_L = 128 * MiB, OUT_Y = 192 * MiB;

constexpr int LDS_BYTES = 155648;
constexpr int LDS_X = 131072;

__device__ __forceinline__ unsigned pk2(float lo, float hi) { f32x2 v = {lo, hi}; bf2_t b = __builtin_convertvector(v, bf2_t); return __builtin_bit_cast(unsigned, b); }
__device__ __forceinline__ u32x2 pk4(f32x4 v) { u32x2 r; r.x = pk2(v[0], v[1]); r.y = pk2(v[2], v[3]); return r; }
__device__ __forceinline__ float bf2f(unsigned short b) { return __uint_as_float((unsigned)b << 16); }
__device__ __forceinline__ f32x4 unpk4(u32x2 w) { f32x4 r; r[0] = __uint_as_float(w.x << 16); r[1] = __uint_as_float(w.x & 0xffff0000u); r[2] = __uint_as_float(w.y << 16); r[3] = __uint_as_float(w.y & 0xffff0000u); return r; }
__device__ __forceinline__ float sigmoidf_(float x) { return __builtin_amdgcn_rcpf(1.0f + __expf(-x)); }
__device__ __forceinline__ float gelu_tanh(float x) { const float z = 1.5957691216057308f * (x + 0.044715f * x * x * x); return x * sigmoidf_(z); }
__device__ __forceinline__ float wave_sum(float v) {
#pragma unroll
    for (int o = 1; o < 64; o <<= 1) v += __shfl_xor(v, o);
    return v;
}
#define LDS_WAIT() asm volatile("s_waitcnt lgkmcnt(0)" ::: "memory")
template <int CTRL> __device__ __forceinline__ float dpp0(float x) { return __builtin_bit_cast(float, __builtin_amdgcn_update_dpp(0, __builtin_bit_cast(int, x), CTRL, 0xf, 0xf, true)); }
template <int CTRL> __device__ __forceinline__ f32x4 dpp4(f32x4 v) { f32x4 r; r[0] = dpp0<CTRL>(v[0]); r[1] = dpp0<CTRL>(v[1]); r[2] = dpp0<CTRL>(v[2]); r[3] = dpp0<CTRL>(v[3]); return r; }

namespace pg8 {
constexpr int BM = 256, BK = 64, HALF = 128, HTB = HALF * BK * 2, STAGE_BYTES = 8 * HTB, NXCD = 8, WGM = 8;
__host__ __device__ __forceinline__ int lds_byte(int r, int c) { const int st = (r >> 4) * 2 + (c >> 5), rr = r & 15, cc = c & 31, ob = rr * 64 + cc * 2; return st * 1024 + (ob ^ (((ob >> 9) & 1) << 5)); }
__host__ __device__ __forceinline__ void stage_rc(int b, int& R, int& C) { const int st = b / 1024, sb = b % 1024, swz = sb ^ (((sb >> 9) & 1) << 5); R = (st >> 1) * 16 + swz / 64; C = (st & 1) * 32 + (swz % 64) / 2; }

struct Unit { int pm, pn, pb; };
struct Gemm { const bf16_t* A; const bf16_t* Bt; };

template <int nM, int nN, int nB>
struct Order {
    static constexpr int nwg = nM * nN * nB;
    int G, c;
    __device__ void init(int G_, int c_) { G = G_; c = c_; }
    __device__ bool next(int i, Unit& u) const {
        const long L = (long)i * G + c; if (L >= nwg) return false;
        int wgid = (int)L; { constexpr int q = nwg / NXCD, r = nwg % NXCD; const int xcd = wgid % NXCD, off = wgid / NXCD; wgid = (xcd < r ? xcd * (q + 1) : r * (q + 1) + (xcd - r) * q) + off; }
        constexpr int per = nM * nN; u.pb = wgid / per; const int w = wgid % per;
        constexpr int nig = WGM * nN; const int gid = w / nig, fm = gid * WGM, gsz = (nM - fm) < WGM ? (nM - fm) : WGM;
        u.pm = fm + ((w % nig) % gsz); u.pn = (w % nig) / gsz; return true;
    }
};

template <int K, int LDA, int LDB, long SA, long SB, class Sched, class Epi>
__device__ __forceinline__ void gemm_phase(LAS unsigned char* lds, const Gemm g, const Sched& S, const Epi& E) {
    const int tid = threadIdx.x, wid = __builtin_amdgcn_readfirstlane(tid >> 6), lane = tid & 63, wr = wid >> 2, wc = wid & 3, fr = lane & 15, fq = lane >> 4;
    constexpr int nt = K / BK;
    unsigned voffA[2], voffB[2];
#pragma unroll
    for (int i = 0; i < 2; ++i) { int R, C; stage_rc(tid * 16 + i * 8192, R, C); voffA[i] = (unsigned)(R * LDA + C) * 2u; voffB[i] = (unsigned)(R * LDB + C) * 2u; }
    constexpr size_t kstep = (size_t)(BK * 2);
    constexpr size_t hstepA = (size_t)HALF * LDA * 2, hstepB = (size_t)HALF * LDB * 2;
    constexpr size_t tstepA = 2 * hstepA, tstepB = 2 * hstepB;
    const unsigned ldsw = (unsigned)wid * 1024u;
    const int aoff = lds_byte(wr * 64 + fr, fq * 8), boff = lds_byte(wc * 32 + fr, fq * 8);
#define PG8_SA(b, h) (((b) * 2 + (h)) * HTB)
#define PG8_SB(b, h) ((4 + (b) * 2 + (h)) * HTB)
#define PG8_STAGE(bufoff, gbase, voff) do { _Pragma("unroll") for (int _i = 0; _i < 2; ++_i) \
        __builtin_amdgcn_global_load_lds((const unsigned*)((const char*)(gbase) + (voff)[_i]), (LAS unsigned*)(lds + (bufoff) + ldsw + _i * 8192), 16, 0, 0); } while (0)
#define PG8_LDA(dst, b, h) do { _Pragma("unroll") for (int m = 0; m < 4; ++m) _Pragma("unroll") for (int k = 0; k < 2; ++k) dst[m][k] = *(const LAS bf16x8*)(lds + PG8_SA(b, h) + aoff + m * 2048 + k * 1024); } while (0)
#define PG8_LDB(dst, b, h) do { _Pragma("unroll") for (int n = 0; n < 2; ++n) _Pragma("unroll") for (int k = 0; k < 2; ++k) dst[n][k] = *(const LAS bf16x8*)(lds + PG8_SB(b, h) + boff + n * 2048 + k * 1024); } while (0)
#define PG8_MMA(ai, bj, At, Bt) do { __builtin_amdgcn_s_setprio(1); _Pragma("unroll") for (int m = 0; m < 4; ++m) _Pragma("unroll") for (int n = 0; n < 2; ++n) _Pragma("unroll") for (int k = 0; k < 2; ++k) \
        acc[ai][bj][m][n] = __builtin_amdgcn_mfma_f32_16x16x32_bf16(Bt[n][k], At[m][k], acc[ai][bj][m][n], 0, 0, 0); __builtin_amdgcn_s_setprio(0); } while (0)
#define PG8_WAIT_V(n) asm volatile("s_waitcnt vmcnt(" #n ")" ::: "memory")
#define PG8_WAIT_L(n) asm volatile("s_waitcnt lgkmcnt(" #n ")" ::: "memory")
#define PG8_BAR __builtin_amdgcn_s_barrier()
#define PG8_SCHED __builtin_amdgcn_sched_barrier(0)
    Unit cur, nxt; int ui = 0;
    if (!S.next(0, cur)) return;
    f32x4 acc[2][2][4][2];
#pragma unroll
    for (int a = 0; a < 2; ++a)
#pragma unroll
        for (int b = 0; b < 2; ++b)
#pragma unroll
            for (int m = 0; m < 4; ++m)
#pragma unroll
                for (int n = 0; n < 2; ++n) acc[a][b][m][n] = (f32x4){0.f, 0.f, 0.f, 0.f};
    bf16x8 At[4][2], B0[2][2], B1[2][2];
    const char* cA = (const char*)g.A + (size_t)cur.pb * (size_t)(SA * 2) + (size_t)cur.pm * tstepA;
    const char* cB = (const char*)g.Bt + (size_t)cur.pb * (size_t)(SB * 2) + (size_t)cur.pn * tstepB;
    PG8_STAGE(PG8_SB(0, 0), cB, voffB); PG8_STAGE(PG8_SB(0, 1), cB + hstepB, voffB); PG8_STAGE(PG8_SA(0, 0), cA, voffA); PG8_STAGE(PG8_SA(0, 1), cA + hstepA, voffA);
    if (wr == 1) PG8_BAR;
    PG8_WAIT_V(2); PG8_BAR;
    PG8_STAGE(PG8_SB(1, 0), cB + kstep, voffB); PG8_STAGE(PG8_SA(1, 0), cA + kstep, voffA); PG8_STAGE(PG8_SB(1, 1), cB + hstepB + kstep, voffB);
    PG8_WAIT_V(6); PG8_BAR;
    for (;;) {
        const bool has_next = S.next(ui + 1, nxt);
        const char* nA = has_next ? (const char*)g.A + (size_t)nxt.pb * (size_t)(SA * 2) + (size_t)nxt.pm * tstepA : cA;
        const char* nB = has_next ? (const char*)g.Bt + (size_t)nxt.pb * (size_t)(SB * 2) + (size_t)nxt.pn * tstepB : cB;
        for (int t = 0; t < nt; t += 2) {
            const bool last = (t == nt - 2);
            const char* a1 = cA + (size_t)(t + 1) * kstep;
            const char* a2 = last ? nA : cA + (size_t)(t + 2) * kstep; const char* b2 = last ? nB : cB + (size_t)(t + 2) * kstep;
            const char* a3 = a2 + kstep; const char* b3 = b2 + kstep;
            PG8_LDB(B0, 0, 0); PG8_LDB(B1, 0, 1); PG8_SCHED; PG8_LDA(At, 0, 0); PG8_STAGE(PG8_SA(1, 1), a1 + hstepA, voffA);
            PG8_WAIT_V(8); PG8_WAIT_L(0); PG8_BAR; PG8_MMA(0, 0, At, B0); PG8_MMA(0, 1, At, B1); PG8_BAR; PG8_SCHED;
            PG8_LDA(At, 0, 1); PG8_STAGE(PG8_SB(0, 0), b2, voffB); PG8_STAGE(PG8_SB(0, 1), b2 + hstepB, voffB); PG8_STAGE(PG8_SA(0, 0), a2, voffA);
            PG8_WAIT_V(8); PG8_WAIT_L(0); PG8_BAR; PG8_MMA(1, 0, At, B0); PG8_MMA(1, 1, At, B1); PG8_BAR; PG8_SCHED;
            PG8_LDB(B0, 1, 0); PG8_LDB(B1, 1, 1); PG8_SCHED; PG8_LDA(At, 1, 0); PG8_STAGE(PG8_SA(0, 1), a2 + hstepA, voffA);
            PG8_WAIT_V(8); PG8_WAIT_L(0); PG8_BAR; PG8_MMA(0, 0, At, B0); PG8_MMA(0, 1, At, B1); PG8_BAR; PG8_SCHED;
            PG8_LDA(At, 1, 1); PG8_STAGE(PG8_SB(1, 0), b3, voffB); PG8_STAGE(PG8_SB(1, 1), b3 + hstepB, voffB); PG8_STAGE(PG8_SA(1, 0), a3, voffA);
            PG8_WAIT_V(8); PG8_WAIT_L(0); PG8_BAR; PG8_MMA(1, 0, At, B0); PG8_MMA(1, 1, At, B1); PG8_BAR; PG8_SCHED;
        }
        if (wr == 0) PG8_BAR;
        E(acc, cur, wr, wc, fr, fq);
        if (!has_next) break;
#pragma unroll
        for (int a = 0; a < 2; ++a)
#pragma unroll
            for (int b = 0; b < 2; ++b)
#pragma unroll
                for (int m = 0; m < 4; ++m)
#pragma unroll
                    for (int n = 0; n < 2; ++n) acc[a][b][m][n] = (f32x4){0.f, 0.f, 0.f, 0.f};
        cur = nxt; cA = nA; cB = nB; ++ui;
        if (wr == 1) PG8_BAR;
    }
    PG8_WAIT_V(0);
    PG8_BAR;
#undef PG8_SA
#undef PG8_SB
#undef PG8_STAGE
#undef PG8_LDA
#undef PG8_LDB
#undef PG8_MMA
#undef PG8_WAIT_V
#undef PG8_WAIT_L
#undef PG8_BAR
#undef PG8_SCHED
}
}
using pg8::Unit;
typedef f32x4 Acc[2][2][4][2];

#define EPI_ROWS(...) _Pragma("unroll") for (int ai = 0; ai < 2; ++ai) _Pragma("unroll") for (int m = 0; m < 4; ++m) { const int row = u.pm * 256 + ai * 128 + wr * 64 + m * 16 + fr; __VA_ARGS__ }
#define EPI_COLS(...) _Pragma("unroll") for (int bj = 0; bj < 2; ++bj) _Pragma("unroll") for (int n = 0; n < 2; ++n) { const int col = u.pn * 256 + bj * 128 + wc * 32 + n * 16 + fq * 4; const f32x4 v = acc[ai][bj][m][n]; __VA_ARGS__ }

struct EpiQKVU {
    bf16_t *q, *k, *vt, *ag;
    __device__ __forceinline__ void operator()(const Acc& acc, const Unit& u, int wr, int wc, int fr, int fq) const {
        asm volatile("" : "+v"(fr), "+v"(fq));
        const int sel = u.pn >> 1;
        EPI_ROWS(
            const size_t tok = (size_t)row;
            EPI_COLS(
                if (sel == 0) { *(u32x2*)(q + tok * 512 + col) = pk4(v); }
                else if (sel == 1) { *(u32x2*)(k + tok * 512 + (col - 512)) = pk4(v); }
                else if (sel == 2) { *(u32x2*)(vt + tok * 512 + (col - 1024)) = pk4(v); }
                else { const int ch = col - 1536, gg = ch >> 4, hh = ch & 15; const int chunk = row >> 5, ii = row & 31;
                    *(u32x2*)(ag + ((size_t)gg * NCH + chunk) * KS + ii * 16 + hh) = pk4(v); }
            )
        )
    }
};
struct EpiLocal {
    float* L;
    __device__ __forceinline__ void operator()(const Acc& acc, const Unit& u, int wr, int wc, int fr, int fq) const {
        asm volatile("" : "+v"(fr), "+v"(fq));
        EPI_ROWS(
            EPI_COLS( *(f32x4*)(L + ((size_t)row * 32 + u.pb) * 256 + col) = v; )
        )
    }
};
struct EpiSsmOut {
    bf16_t* y;
    __device__ __forceinline__ void operator()(const Acc& acc, const Unit& u, int wr, int wc, int fr, int fq) const {
        asm volatile("" : "+v"(fr), "+v"(fq));
        EPI_ROWS(
            EPI_COLS(
                const int ii = col >> 4, hh = col & 15; const size_t tok = (size_t)row * 32 + ii;
                f32x4 o; o[0] = gelu_tanh(v[0]); o[1] = gelu_tanh(v[1]); o[2] = gelu_tanh(v[2]); o[3] = gelu_tanh(v[3]);
                *(u32x2*)(y + tok * 512 + u.pb * 16 + hh) = pk4(o);
            )
        )
    }
};
struct EpiGlu {
    const bf16_t* y; const float* bglu; bf16_t* o;
    __device__ __forceinline__ void operator()(const Acc& acc, const Unit& u, int wr, int wc, int fr, int fq) const {
        asm volatile("" : "+v"(fr), "+v"(fq));
        EPI_ROWS(
            EPI_COLS(
                const f32x4 yv = unpk4(*(const u32x2*)(y + (size_t)row * 512 + col)); const f32x4 bv = *(const f32x4*)(bglu + col);
                f32x4 r; r[0] = yv[0] * sigmoidf_(v[0] + bv[0]); r[1] = yv[1] * sigmoidf_(v[1] + bv[1]); r[2] = yv[2] * sigmoidf_(v[2] + bv[2]); r[3] = yv[3] * sigmoidf_(v[3] + bv[3]);
                *(u32x2*)(o + (size_t)row * 512 + col) = pk4(r);
            )
        )
    }
};
struct EpiT {
    bf16_t* T;
    __device__ __forceinline__ void operator()(const Acc& acc, const Unit& u, int wr, int wc, int fr, int fq) const {
        asm volatile("" : "+v"(fr), "+v"(fq));
        bf16_t* base = T + (size_t)u.pb * M * 1024;
        EPI_ROWS(
            EPI_COLS( *(u32x2*)(base + (size_t)row * 1024 + col) = pk4(v); )
        )
    }
};
struct EpiGate {
    bf16_t* T;
    __device__ __forceinline__ void operator()(const Acc& acc, const Unit& u, int wr, int wc, int fr, int fq) const {
        asm volatile("" : "+v"(fr), "+v"(fq));
        bf16_t* T1 = T; const bf16_t* T2 = T + (size_t)M * 1024;
        EPI_ROWS(
            _Pragma("unroll")
            for (int n = 0; n < 2; ++n) {
                const int c = u.pn * 128 + wc * 32 + n * 16 + fq * 4;
                const f32x4 ga = acc[ai][0][m][n], gs = acc[ai][1][m][n];
                const f32x4 t1 = unpk4(*(const u32x2*)(T1 + (size_t)row * 1024 + c)), t2 = unpk4(*(const u32x2*)(T2 + (size_t)row * 1024 + c));
                f32x4 r;
                _Pragma("unroll")
                for (int e = 0; e < 4; ++e) r[e] = sigmoidf_(ga[e]) * t1[e] + sigmoidf_(gs[e]) * t2[e];
                *(u32x2*)(T1 + (size_t)row * 1024 + c) = pk4(r);
            }
        )
    }
};
struct EpiOutF32 {
    float* y; float* rowsq;
    __device__ __forceinline__ void operator()(const Acc& acc, const Unit& u, int wr, int wc, int fr, int fq) const {
        asm volatile("" : "+v"(fr), "+v"(fq));
        EPI_ROWS(
            float s = 0.f;
            EPI_COLS( *(f32x4*)(y + (size_t)row * 1024 + col) = v; s += (v[0] * v[0] + v[1] * v[1]) + (v[2] * v[2] + v[3] * v[3]); )
            s += __shfl_xor(s, 16); s += __shfl_xor(s, 32);
            if (fq == 0) atomicAdd(rowsq + row, s);
        )
    }
};
struct EpiOutBf16 {
    bf16_t* y; float* rowsq;
    __device__ __forceinline__ void operator()(const Acc& acc, const Unit& u, int wr, int wc, int fr, int fq) const {
        asm volatile("" : "+v"(fr), "+v"(fq));
        EPI_ROWS(
            float s = 0.f;
            EPI_COLS( *(u32x2*)(y + (size_t)row * 1024 + col) = pk4(v); s += (v[0] * v[0] + v[1] * v[1]) + (v[2] * v[2] + v[3] * v[3]); )
            s += __shfl_xor(s, 16); s += __shfl_xor(s, 32);
            if (fq == 0) atomicAdd(rowsq + row, s);
        )
    }
};
#ifndef EPIUP_SB
#define EPIUP_SB
#endif
struct EpiUp {
    bf16_t* act; bf16_t* E; const float* cwt; LAS float* X;
    __device__ __forceinline__ void operator()(const Acc& acc, const Unit& u, int wr, int wc, int fr, int fq) const {
        asm volatile("" : "+v"(fr), "+v"(fq));
#pragma unroll
        for (int ai = 0; ai < 2; ++ai) {
            const int qrow = 2 * ai + wr;
#pragma unroll
            for (int bj = 0; bj < 2; ++bj)
#pragma unroll
                for (int n = 0; n < 2; ++n) {
                    const int cidx = bj * 128 + wc * 32 + n * 16 + fq * 4;
                    if (fr == 0) *(LAS f32x4*)(X + (2 * qrow + 0) * 256 + cidx) = acc[ai][bj][0][n];
                    if (fr == 15) *(LAS f32x4*)(X + (2 * qrow + 1) * 256 + cidx) = acc[ai][bj][3][n];
                    if (qrow == 0 && fr < 2) *(u32x2*)(E + ((size_t)u.pm * 4 + fr) * NUP + u.pn * 256 + cidx) = pk4(acc[ai][bj][0][n]);
                    if (qrow == 3 && fr >= 14) *(u32x2*)(E + ((size_t)u.pm * 4 + (fr - 12)) * NUP + u.pn * 256 + cidx) = pk4(acc[ai][bj][3][n]);
                }
        }
        asm volatile("s_waitcnt lgkmcnt(0)" ::: "memory"); __builtin_amdgcn_s_barrier(); asm volatile("" ::: "memory");
        const float first = fr == 0 ? 1.f : 0.f, lastf = fr == 15 ? 1.f : 0.f;
#pragma unroll
        for (int n = 0; n < 2; ++n) {
            const int ca = wc * 32 + n * 16 + fq * 4;
            const int j = u.pn * 128 + ca;
            const f32x4* wt = (const f32x4*)(cwt + (size_t)(j >> 2) * 32);
            const f32x4 wa0 = wt[0], wa1 = wt[1], wa2 = wt[2], ba = wt[3], wb0 = wt[4], wb1 = wt[5], wb2 = wt[6], bb = wt[7];
#pragma unroll
            for (int ai = 0; ai < 2; ++ai) {
                const int qrow = 2 * ai + wr;
                const int sp = qrow > 0 ? 2 * (qrow - 1) + 1 : 0, sn = qrow < 3 ? 2 * (qrow + 1) : 0;
                const float fp = qrow > 0 ? first : 0.f, fn = qrow < 3 ? lastf : 0.f;
#pragma unroll
                for (int m = 0; m < 4; ++m) {
                    const f32x4 a_c = acc[ai][0][m][n], b_c = acc[ai][1][m][n];
                    f32x4 a_p = dpp4<0x111>(a_c), b_p = dpp4<0x111>(b_c), a_n = dpp4<0x101>(a_c), b_n = dpp4<0x101>(b_c);
                    if (m > 0) { a_p += dpp4<0x10F>(acc[ai][0][m > 0 ? m - 1 : 0][n]); b_p += dpp4<0x10F>(acc[ai][1][m > 0 ? m - 1 : 0][n]); }
                    else { a_p += *(const LAS f32x4*)(X + sp * 256 + ca) * fp; b_p += *(const LAS f32x4*)(X + sp * 256 + 128 + ca) * fp; }
                    if (m < 3) { a_n += dpp4<0x11F>(acc[ai][0][m < 3 ? m + 1 : 3][n]); b_n += dpp4<0x11F>(acc[ai][1][m < 3 ? m + 1 : 3][n]); }
                    else { a_n += *(const LAS f32x4*)(X + sn * 256 + ca) * fn; b_n += *(const LAS f32x4*)(X + sn * 256 + 128 + ca) * fn; }
                    const int rt = ai * 128 + wr * 64 + m * 16 + fr;
                    f32x4 r;
#pragma unroll
                    for (int e = 0; e < 4; ++e) {
                        const float av = wa0[e] * a_p[e] + wa1[e] * a_c[e] + wa2[e] * a_n[e] + ba[e];
                        const float bv = wb0[e] * b_p[e] + wb1[e] * b_c[e] + wb2[e] * b_n[e] + bb[e];
                        r[e] = gelu_tanh(av) * bv;
                    }
                    if (rt != 0 && rt != 255) *(u32x2*)(act + ((size_t)u.pm * 256 + rt) * DFF + j) = pk4(r);
                    EPIUP_SB;
                }
            }
        }
    }
};

struct Params { const float* in[25]; float* out; unsigned char* ws; int ph_lo, ph_hi; };
enum { I_XP = 0, I_XS, I_GMPRE, I_GMPOST, I_WIN, I_RPB, I_LRE, I_LIM, I_LDT, I_BRE, I_BIM, I_CRE, I_CIM, I_SD, I_WGLU, I_BGLU, I_WBA, I_WBS, I_WOUT, I_GFPRE, I_GFPOST, I_WUP, I_CW, I_CB, I_WDOWN };

__device__ __forceinline__ const float* xrow_ptr(const Params& p, int tok) { return tok < MP ? p.in[I_XP] + (size_t)tok * D : p.in[I_XS] + (size_t)(tok - MP) * D; }

__device__ __forceinline__ void transpose_item(const float* W, int ldw, int K, int srccol0, bf16_t* WT, int destrow0, float scale, LAS float* scr, int kb, int lane) {
    const int k0 = 64 * kb;
#pragma unroll 8
    for (int i = 0; i < 32; ++i) { const int kk = 2 * i + (lane >> 5); scr[kk * 33 + (lane & 31)] = W[(size_t)(k0 + kk) * ldw + srccol0 + (lane & 31)]; }
    LDS_WAIT(); asm volatile("" ::: "memory");
    const int c = lane & 7;
#pragma unroll
    for (int j = 0; j < 4; ++j) { const int n = (lane >> 3) + 8 * j; const LAS float* s = scr + (8 * c) * 33 + n;
        u32x4 o; o.x = pk2(s[0 * 33] * scale, s[1 * 33] * scale); o.y = pk2(s[2 * 33] * scale, s[3 * 33] * scale); o.z = pk2(s[4 * 33] * scale, s[5 * 33] * scale); o.w = pk2(s[6 * 33] * scale, s[7 * 33] * scale);
        *(u32x4*)(WT + (size_t)(destrow0 + n) * K + k0 + 8 * c) = o; }
    LDS_WAIT(); asm volatile("" ::: "memory");
}

struct cplx { float x, y; };
__device__ __forceinline__ cplx cmul(cplx a, cplx b) { return {a.x * b.x - a.y * b.y, a.x * b.y + a.y * b.x}; }
__device__ __forceinline__ cplx cexp_scaled(float lre, float lim, float s) { const float mag = expf(lre * s); float sn, cs; sincosf(lim * s, &sn, &cs); return {mag * cs, mag * sn}; }
__device__ __forceinline__ cplx zoh_coef(float lre, float lim, float dt) {
    const cplx lb = cexp_scaled(lre, lim, dt); const float nx = lb.x - 1.0f, ny = lb.y; const float inv = 1.0f / (lre * lre + lim * lim);
    return {(nx * lre + ny * lim) * inv, (ny * lre - nx * lim) * inv};
}

__device__ __forceinline__ void phase0_prep(const Params& p, LAS unsigned char* lds, int tid, int lane, int wave) {
    unsigned char* ws = p.ws;
    const int G = gridDim.x, blk = blockIdx.x;
    const int gw = blk * 8 + wave, NGW = G * 8;
    const int gt = blk * 512 + tid, NGT = G * 512;
    { float* z = (float*)(ws + WS_ROWSQ1); for (int i = gt; i < 2 * M; i += NGT) z[i] = 0.f; }
    { float* t = (float*)(ws + WS_CWT); const float* cw = p.in[I_CW]; const float* cb = p.in[I_CB];
      for (int i = gt; i < (DFF / 4) * 32; i += NGT) { const int e = i & 3, k = (i >> 2) & 7, j = (i >> 5) * 4 + e; const int col = (k >= 4 ? DFF : 0) + j; const int kk = k & 3;
          t[i] = kk < 3 ? cw[kk * NUP + col] : cb[col]; } }
    {
        bf16_t* xb = (bf16_t*)(ws + WS_XB); const float* gp = p.in[I_GMPRE];
        f32x4 gv[4];
#pragma unroll
        for (int j = 0; j < 4; ++j) gv[j] = *(const f32x4*)(gp + 4 * (lane + 64 * j));
        for (int tok = gw; tok < M; tok += NGW) {
            const f32x4* xr = (const f32x4*)xrow_ptr(p, tok) + lane;
            f32x4 v[4]; float s = 0.f;
#pragma unroll
            for (int j = 0; j < 4; ++j) { v[j] = xr[64 * j]; s += (v[j][0] * v[j][0] + v[j][1] * v[j][1]) + (v[j][2] * v[j][2] + v[j][3] * v[j][3]); }
            const float rstd = rsqrtf(wave_sum(s) * (1.0f / D) + EPS);
            u32x2* o = (u32x2*)(xb + (size_t)tok * D) + lane;
#pragma unroll
            for (int j = 0; j < 4; ++j) { f32x4 r = v[j] * rstd * gv[j]; o[64 * j] = pk4(r); }
        }
    }
    {
        LAS float* scr = (LAS float*)(lds + wave * 16384);
        constexpr int I0 = 16 * 64;
        constexpr int I1 = 16 * 64;
        constexpr int I2 = 8 * 16;
        constexpr int I3 = 8 * 32;
        constexpr int I4 = 8 * 32;
        constexpr int I5 = 16 * 32;
        constexpr int I6 = 16 * 176;
        constexpr int I7 = 44 * 32;
        constexpr int NIT = I0 + I1 + I2 + I3 + I4 + I5 + I6 + I7;
        for (int it = gw; it < NIT; it += NGW) {
            int r = it;
            if (r < I0) { const int nb = r % 64, kb = r / 64, n0 = nb * 32; transpose_item(p.in[I_WIN], 4096, 1024, n0, (bf16_t*)(ws + WS_WIN1), n0, n0 < 512 ? 0.125f : 1.0f, scr, kb, lane); continue; } r -= I0;
            if (r < I1) { const int nb = r % 64, kb = r / 64, n0 = nb * 32; const int src = 2048 + ((n0 >> 7) & 1) * 1024 + (n0 >> 8) * 128 + (n0 & 127);
                          transpose_item(p.in[I_WIN], 4096, 1024, src, (bf16_t*)(ws + WS_WG), n0, 1.0f, scr, kb, lane); continue; } r -= I1;
            if (r < I2) { const int nb = r % 16, kb = r / 16, n0 = nb * 32; transpose_item(p.in[I_WGLU], 512, 512, n0, (bf16_t*)(ws + WS_WGLU), n0, 1.0f, scr, kb, lane); continue; } r -= I2;
            if (r < I3) { const int nb = r % 32, kb = r / 32, n0 = nb * 32; transpose_item(p.in[I_WBA], 1024, 512, n0, (bf16_t*)(ws + WS_WBR), n0, 1.0f, scr, kb, lane); continue; } r -= I3;
            if (r < I4) { const int nb = r % 32, kb = r / 32, n0 = nb * 32; transpose_item(p.in[I_WBS], 1024, 512, n0, (bf16_t*)(ws + WS_WBR) + (size_t)1024 * 512, n0, 1.0f, scr, kb, lane); continue; } r -= I4;
            if (r < I5) { const int nb = r % 32, kb = r / 32, n0 = nb * 32; transpose_item(p.in[I_WOUT], 1024, 1024, n0, (bf16_t*)(ws + WS_WOUT), n0, 1.0f, scr, kb, lane); continue; } r -= I5;
            if (r < I6) { const int nb = r % 176, kb = r / 176, n0 = nb * 32; const int src = ((n0 >> 7) & 1) * DFF + (n0 >> 8) * 128 + (n0 & 127);
                          transpose_item(p.in[I_WUP], NUP, 1024, src, (bf16_t*)(ws + WS_WUP), n0, 1.0f, scr, kb, lane); continue; } r -= I6;
            { const int nb = r % 32, kb = r / 32, n0 = nb * 32; transpose_item(p.in[I_WDOWN], 1024, DFF, n0, (bf16_t*)(ws + WS_WDOWN), n0, 1.0f, scr, kb, lane); }
        }
    }
    __syncthreads();
    const float* lre = p.in[I_LRE]; const float* lim = p.in[I_LIM]; const float* ldt = p.in[I_LDT];
    const float* bre = p.in[I_BRE]; const float* bim = p.in[I_BIM]; const float* cre = p.in[I_CRE]; const float* cim = p.in[I_CIM];
    bf16_t* Wssm = (bf16_t*)(ws + WS_WSSM); bf16_t* Pssm = (bf16_t*)(ws + WS_PSSM);
    {
        LAS float* Fs = (LAS float*)lds;
        for (int it = blk; it < NG * 63; it += G) {
            const int g = it / 63, d = it % 63 - 31, e = d < 0 ? -d : d;
            __syncthreads();
            if (tid < 128) {
                const int dir = tid >> 6, pp = tid & 63; const bool use = dir == 0 ? (d >= 0) : (d <= 0);
                const float a = lre[(dir * NG + g) * 64 + pp], b = lim[(dir * NG + g) * 64 + pp], dt = expf(ldt[dir * NG + g]);
                cplx F = cmul(cexp_scaled(a, b, dt * (float)e), zoh_coef(a, b, dt));
                if (!use) { F.x = 0.f; F.y = 0.f; }
                Fs[(dir * 64 + pp) * 2 + 0] = F.x; Fs[(dir * 64 + pp) * 2 + 1] = F.y;
            }
            __syncthreads();
            if (tid < 256) {
                const int h = tid >> 4, hp = tid & 15; float accv = 0.f;
                for (int dir = 0; dir < 2; ++dir)
                    for (int pp = 0; pp < 64; ++pp) {
                        const cplx c = {cre[((dir * NG + g) * 16 + h) * 64 + pp], cim[((dir * NG + g) * 16 + h) * 64 + pp]};
                        const cplx bq = {bre[((dir * NG + g) * 64 + pp) * 16 + hp], bim[((dir * NG + g) * 64 + pp) * 16 + hp]};
                        const cplx F = {Fs[(dir * 64 + pp) * 2 + 0], Fs[(dir * 64 + pp) * 2 + 1]};
                        const cplx cf = cmul(c, F);
                        accv += cf.x * bq.x - cf.y * bq.y;
                    }
                if (d == 0 && h == hp) accv += p.in[I_SD][16 * g + h];
                const bf16_t w = (bf16_t)(pk2(accv, 0.f) & 0xffffu);
                const int i0 = d > 0 ? d : 0, i1 = d < 0 ? 31 + d : 31;
                for (int i = i0; i <= i1; ++i) { const int s = i - d; Wssm[((size_t)g * 512 + i * 16 + h) * KS + s * 16 + hp] = w; }
            }
        }
        __syncthreads();
    }
    for (int idx = gt; idx < NG * 32 * 16 * 2 * 64; idx += NGT) {
        const int pp = idx & 63, dir = (idx >> 6) & 1, h = (idx >> 7) & 15, i = (idx >> 11) & 31, g = idx >> 16;
        const float a = lre[(dir * NG + g) * 64 + pp], b = lim[(dir * NG + g) * 64 + pp], dt = expf(ldt[dir * NG + g]);
        const int e = dir == 0 ? i + 1 : 32 - i;
        const cplx c = {cre[((dir * NG + g) * 16 + h) * 64 + pp], cim[((dir * NG + g) * 16 + h) * 64 + pp]};
        const cplx cl = cmul(c, cexp_scaled(a, b, dt * (float)e));
        bf16_t* dst = Wssm + ((size_t)g * 512 + i * 16 + h) * KS + 512 + dir * 128 + pp;
        dst[0] = (bf16_t)(pk2(cl.x, 0.f) & 0xffffu); dst[64] = (bf16_t)(pk2(-cl.y, 0.f) & 0xffffu);
    }
    for (int idx = gt; idx < NG * 2 * 64 * 32 * 16; idx += NGT) {
        const int hp = idx & 15, s = (idx >> 4) & 31, pp = (idx >> 9) & 63, dir = (idx >> 15) & 1, g = idx >> 16;
        const float a = lre[(dir * NG + g) * 64 + pp], b = lim[(dir * NG + g) * 64 + pp], dt = expf(ldt[dir * NG + g]);
        const int e = dir == 0 ? 31 - s : s;
        const cplx bq = {bre[((dir * NG + g) * 64 + pp) * 16 + hp], bim[((dir * NG + g) * 64 + pp) * 16 + hp]};
        const cplx v = cmul(cmul(cexp_scaled(a, b, dt * (float)e), zoh_coef(a, b, dt)), bq);
        bf16_t* dst = Pssm + ((size_t)g * 256 + dir * 128 + pp) * 512 + s * 16 + hp;
        dst[0] = (bf16_t)(pk2(v.x, 0.f) & 0xffffu); dst[(size_t)64 * 512] = (bf16_t)(pk2(v.y, 0.f) & 0xffffu);
    }
}

typedef short v4i16_t __attribute__((ext_vector_type(4)));
constexpr int ATT_K = 0, ATT_V = 73728, ATT_RPB = 147456;
__device__ __forceinline__ u32x2 vtr(LAS unsigned char* p) { return __builtin_bit_cast(u32x2, __builtin_amdgcn_ds_read_tr16_b64_v4i16((LAS v4i16_t*)p)); }
__device__ __forceinline__ void attn_phase(const bf16_t* __restrict__ qb, const bf16_t* __restrict__ kb, const bf16_t* __restrict__ vb, bf16_t* __restrict__ att, const float* __restrict__ rpb,
                                           LAS unsigned char* lds, int tid, int wave, int lane) {
    const int G = gridDim.x;
    const int qi = lane & 15, q4 = lane >> 4, n = wave & 3, half = wave >> 2;
    const int c = 16 * n + qi;
    int cs = c - 8; cs = cs < 0 ? 0 : (cs > 48 ? 48 : cs);
    int bs = 16 * n - 8; bs = bs < 0 ? 0 : (bs > 32 ? 32 : bs);
    const int kswz = ((bs >> 1) + (qi >> 1)) & 7;
    const int koff0 = (bs + qi) * 128, kx0 = (q4 ^ kswz) << 4, kx1 = ((4 + q4) ^ kswz) << 4;
    const int vtok = bs + 4 * q4 + (qi >> 2), vsw = (vtok >> 1) & 3;
    const int voff0 = vtok * 128 + (qi & 3) * 8;
    const int stok = tid >> 3, sc = tid & 7;
    const int skoff = stok * 128 + ((sc ^ ((stok >> 1) & 7)) << 4);
    const int svoff = stok * 128 + (((sc >> 1) ^ ((stok >> 1) & 3)) * 32) + (sc & 1) * 16;
    LAS float* rp = (LAS float*)(lds + ATT_RPB);
    for (int s = blockIdx.x; s < 256; s += G) {
        const int h = s & 7, ss = s >> 3;
        int rows, Rbase, r0;
        if (ss < 16) { rows = 64; Rbase = (ss >> 1) * 64; r0 = (ss & 1) * 32; } else { rows = 32; Rbase = 512 + (ss - 16) * 32; r0 = 0; }
        for (int i = tid; i < 465; i += 512) rp[i] = rpb[h * 465 + i];
#define RSF(r_) ((r_) - 4 < 0 ? 0 : ((r_) - 4 > rows - 8 ? rows - 8 : (r_) - 4))
        const size_t gcol = (size_t)h * 64 + sc * 8;
        {
            const int lo_row = RSF(r0), hi_row = RSF(r0 + 1) + 7;
            for (int kr = lo_row; kr <= hi_row; ++kr) {
                const size_t gofs = ((size_t)(Rbase + kr) * 64 + stok) * 512 + gcol;
                const u32x4 kv = *(const u32x4*)(kb + gofs), vv = *(const u32x4*)(vb + gofs);
                const int slot = (kr % 9) * 8192;
                *(LAS u32x4*)(lds + ATT_K + slot + skoff) = kv; *(LAS u32x4*)(lds + ATT_V + slot + svoff) = vv;
            }
        }
        int loaded_hi = RSF(r0 + 1) + 7;
        const int myr0 = r0 + half;
        bf16x8 qf0, qf1;
        { const size_t tokq = (size_t)(Rbase + myr0) * 64 + c; qf0 = *(const bf16x8*)(qb + tokq * 512 + h * 64 + q4 * 8); qf1 = *(const bf16x8*)(qb + tokq * 512 + h * 64 + 32 + q4 * 8); }
        __syncthreads();
        for (int it = 0; it < 16; ++it) {
            const int r = myr0 + 2 * it;
            int need_hi = loaded_hi;
            if (it < 15) need_hi = RSF(r0 + 2 * (it + 1) + 1) + 7;
            const int npre = need_hi - loaded_hi;
            u32x4 kp0, vp0, kp1, vp1; bf16x8 qn0 = qf0, qn1 = qf1;
            if (npre >= 1) { const size_t gofs = ((size_t)(Rbase + loaded_hi + 1) * 64 + stok) * 512 + gcol; kp0 = *(const u32x4*)(kb + gofs); vp0 = *(const u32x4*)(vb + gofs); }
            if (npre >= 2) { const size_t gofs = ((size_t)(Rbase + loaded_hi + 2) * 64 + stok) * 512 + gcol; kp1 = *(const u32x4*)(kb + gofs); vp1 = *(const u32x4*)(vb + gofs); }
            if (it < 15) { const size_t tokn = (size_t)(Rbase + r + 2) * 64 + c; qn0 = *(const bf16x8*)(qb + tokn * 512 + h * 64 + q4 * 8); qn1 = *(const bf16x8*)(qb + tokn * 512 + h * 64 + 32 + q4 * 8); }
            const int rs = RSF(r);
            const int sb = rs % 9;
            f32x4 st[8][2];
#pragma unroll
            for (int kr = 0; kr < 8; ++kr) {
                int slot = sb + kr; slot = slot >= 9 ? slot - 9 : slot;
                LAS unsigned char* kbase = lds + ATT_K + slot * 8192 + koff0;
#pragma unroll
                for (int hf = 0; hf < 2; ++hf) {
                    const bf16x8 k0 = *(const LAS bf16x8*)(kbase + hf * 2048 + kx0);
                    const bf16x8 k1 = *(const LAS bf16x8*)(kbase + hf * 2048 + kx1);
                    f32x4 a = {0.f, 0.f, 0.f, 0.f};
                    a = __builtin_amdgcn_mfma_f32_16x16x32_bf16(k0, qf0, a, 0, 0, 0);
                    a = __builtin_amdgcn_mfma_f32_16x16x32_bf16(k1, qf1, a, 0, 0, 0);
                    st[kr][hf] = a;
                }
            }
            float mx = -1e30f;
#pragma unroll
            for (int kr = 0; kr < 8; ++kr) {
                const LAS float* brow = rp + (rs + kr - r + 7) * 31;
#pragma unroll
                for (int hf = 0; hf < 2; ++hf)
#pragma unroll
                    for (int e = 0; e < 4; ++e) {
                        const int kc = bs + 16 * hf + 4 * q4 + e; const bool valid = (kc >= cs) && (kc < cs + 16);
                        int dc = kc - c + 15; dc = dc < 0 ? 0 : (dc > 30 ? 30 : dc);
                        const float sv = valid ? st[kr][hf][e] + brow[dc] : -1e30f;
                        st[kr][hf][e] = sv; mx = fmaxf(mx, sv);
                    }
            }
            mx = fmaxf(mx, __shfl_xor(mx, 16)); mx = fmaxf(mx, __shfl_xor(mx, 32));
            float l = 0.f;
#pragma unroll
            for (int kr = 0; kr < 8; ++kr)
#pragma unroll
                for (int hf = 0; hf < 2; ++hf)
#pragma unroll
                    for (int e = 0; e < 4; ++e) { const float pv = __expf(st[kr][hf][e] - mx); st[kr][hf][e] = pv; l += pv; }
            l += __shfl_xor(l, 16); l += __shfl_xor(l, 32);
            f32x4 o[4];
#pragma unroll
            for (int dt = 0; dt < 4; ++dt) o[dt] = (f32x4){0.f, 0.f, 0.f, 0.f};
#pragma unroll
            for (int kr = 0; kr < 8; ++kr) {
                u32x4 pw; pw.x = pk2(st[kr][0][0], st[kr][0][1]); pw.y = pk2(st[kr][0][2], st[kr][0][3]); pw.z = pk2(st[kr][1][0], st[kr][1][1]); pw.w = pk2(st[kr][1][2], st[kr][1][3]);
                const bf16x8 pf = __builtin_bit_cast(bf16x8, pw);
                int slot = sb + kr; slot = slot >= 9 ? slot - 9 : slot;
                LAS unsigned char* vbase = lds + ATT_V + slot * 8192 + voff0;
#pragma unroll
                for (int dt = 0; dt < 4; ++dt) {
                    const u32x2 v0 = vtr(vbase + ((dt ^ vsw) * 32)), v1 = vtr(vbase + 2048 + ((dt ^ vsw) * 32));
                    u32x4 vw; vw.x = v0.x; vw.y = v0.y; vw.z = v1.x; vw.w = v1.y;
                    o[dt] = __builtin_amdgcn_mfma_f32_16x16x32_bf16(__builtin_bit_cast(bf16x8, vw), pf, o[dt], 0, 0, 0);
                }
            }
            const float inv = 1.0f / l;
            const size_t tokq = (size_t)(Rbase + r) * 64 + c;
#pragma unroll
            for (int dt = 0; dt < 4; ++dt) { f32x4 rr = o[dt] * inv; *(u32x2*)(att + tokq * 512 + h * 64 + dt * 16 + 4 * q4) = pk4(rr); }
            __syncthreads();
            if (npre >= 1) { const int slot = ((loaded_hi + 1) % 9) * 8192; *(LAS u32x4*)(lds + ATT_K + slot + skoff) = kp0; *(LAS u32x4*)(lds + ATT_V + slot + svoff) = vp0; }
            if (npre >= 2) { const int slot = ((loaded_hi + 2) % 9) * 8192; *(LAS u32x4*)(lds + ATT_K + slot + skoff) = kp1; *(LAS u32x4*)(lds + ATT_V + slot + svoff) = vp1; }
            loaded_hi = need_hi; qf0 = qn0; qf1 = qn1;
            __syncthreads();
        }
#undef RSF
    }
}

__device__ __forceinline__ void scan_phase(const Params& p, const float* __restrict__ Lb, bf16_t* __restrict__ ag, int tid) {
    const int gt = blockIdx.x * 512 + tid, NGT = gridDim.x * 512;
    for (int idx = gt; idx < 24 * NG * 2 * 64; idx += NGT) {
        const int pp = idx & 63, dir = (idx >> 6) & 1, g = (idx >> 7) & 31, seq = idx >> 12;
        const int nch = seq < 8 ? 128 : 64, ch0 = seq < 8 ? seq * 128 : 1024 + (seq - 8) * 64;
        const float a = p.in[I_LRE][(dir * NG + g) * 64 + pp], b = p.in[I_LIM][(dir * NG + g) * 64 + pp], dt = expf(p.in[I_LDT][dir * NG + g]);
        const cplx lt = cexp_scaled(a, b, dt * (float)TCH);
        float hx = 0.f, hy = 0.f;
        const int colr = dir * 128 + pp;
        for (int c0 = 0; c0 < nch; c0 += 8) {
            float lr[8], li[8];
#pragma unroll
            for (int j = 0; j < 8; ++j) { const int cc = dir == 0 ? c0 + j : nch - 1 - (c0 + j); const float* src = Lb + ((size_t)(ch0 + cc) * 32 + g) * 256 + colr; lr[j] = src[0]; li[j] = src[64]; }
#pragma unroll
            for (int j = 0; j < 8; ++j) {
                const int cc = dir == 0 ? c0 + j : nch - 1 - (c0 + j);
                bf16_t* dst = ag + ((size_t)g * NCH + ch0 + cc) * KS + 512 + colr;
                dst[0] = (bf16_t)(pk2(hx, 0.f) & 0xffffu); dst[64] = (bf16_t)(pk2(hy, 0.f) & 0xffffu);
                const float nx = lt.x * hx - lt.y * hy + lr[j], ny = lt.x * hy + lt.y * hx + li[j];
                hx = nx; hy = ny;
            }
        }
    }
}

__device__ __forceinline__ void norm_phase(const Params& p, int lane, int wave) {
    const int gw = blockIdx.x * 8 + wave, NGW = gridDim.x * 8;
    const float* rowsq1 = (const float*)(p.ws + WS_ROWSQ1); bf16_t* xb = (bf16_t*)(p.ws + WS_XB);
    f32x4 g1[4], g2[4];
#pragma unroll
    for (int j = 0; j < 4; ++j) { g1[j] = *(const f32x4*)(p.in[I_GMPOST] + 4 * (lane + 64 * j)); g2[j] = *(const f32x4*)(p.in[I_GFPRE] + 4 * (lane + 64 * j)); }
    for (int tok = gw; tok < M; tok += NGW) {
        const f32x4* xr = (const f32x4*)xrow_ptr(p, tok) + lane; f32x4* yr = (f32x4*)(p.out + (size_t)tok * D) + lane;
        const float rstd1 = rsqrtf(rowsq1[tok] * (1.0f / D) + EPS);
        f32x4 v[4]; float s = 0.f;
#pragma unroll
        for (int j = 0; j < 4; ++j) { v[j] = xr[64 * j] + yr[64 * j] * rstd1 * g1[j]; s += (v[j][0] * v[j][0] + v[j][1] * v[j][1]) + (v[j][2] * v[j][2] + v[j][3] * v[j][3]); }
        const float rstd2 = rsqrtf(wave_sum(s) * (1.0f / D) + EPS);
        u32x2* o = (u32x2*)(xb + (size_t)tok * D) + lane;
#pragma unroll
        for (int j = 0; j < 4; ++j) { yr[64 * j] = v[j]; f32x4 r = v[j] * rstd2 * g2[j]; o[64 * j] = pk4(r); }
    }
}
__device__ __forceinline__ void fixup_phase(const Params& p, int tid) {
    const int gt = blockIdx.x * 512 + tid, NGT = gridDim.x * 512;
    const bf16_t* E = (const bf16_t*)(p.ws + WS_E); bf16_t* act = (bf16_t*)(p.ws + WS_ACT); const float* cw = p.in[I_CW]; const float* cb = p.in[I_CB];
    for (int idx = gt; idx < 256 * 2 * (DFF / 4); idx += NGT) {
        const int j = (idx % (DFF / 4)) * 4, which = (idx / (DFF / 4)) & 1, pm = idx / (2 * (DFF / 4));
        const bool seq_first = pm < 128 ? (pm % 16 == 0) : ((pm - 128) % 8 == 0), seq_last = pm < 128 ? (pm % 16 == 15) : ((pm - 128) % 8 == 7);
        const int ec = (j >> 7) * 256 + (j & 127);
        const f32x4 z4 = {0.f, 0.f, 0.f, 0.f};
        f32x4 ap, ac, an, bp, bc, bn;
        auto ld = [&](int tile, int slot, int coff) { return unpk4(*(const u32x2*)(E + ((size_t)tile * 4 + slot) * NUP + ec + coff)); };
        if (which == 0) { ac = ld(pm, 0, 0); bc = ld(pm, 0, 128); an = ld(pm, 1, 0); bn = ld(pm, 1, 128);
            if (seq_first) { ap = z4; bp = z4; } else { ap = ld(pm - 1, 3, 0); bp = ld(pm - 1, 3, 128); } }
        else { ap = ld(pm, 2, 0); bp = ld(pm, 2, 128); ac = ld(pm, 3, 0); bc = ld(pm, 3, 128);
            if (seq_last) { an = z4; bn = z4; } else { an = ld(pm + 1, 0, 0); bn = ld(pm + 1, 0, 128); } }
        const f32x4 wa0 = *(const f32x4*)(cw + j), wa1 = *(const f32x4*)(cw + NUP + j), wa2 = *(const f32x4*)(cw + 2 * NUP + j), ba = *(const f32x4*)(cb + j);
        const f32x4 wb0 = *(const f32x4*)(cw + DFF + j), wb1 = *(const f32x4*)(cw + NUP + DFF + j), wb2 = *(const f32x4*)(cw + 2 * NUP + DFF + j), bb = *(const f32x4*)(cb + DFF + j);
        f32x4 r;
#pragma unroll
        for (int e = 0; e < 4; ++e) {
            const float av = wa0[e] * ap[e] + wa1[e] * ac[e] + wa2[e] * an[e] + ba[e];
            const float bv = wb0[e] * bp[e] + wb1[e] * bc[e] + wb2[e] * bn[e] + bb[e];
            r[e] = gelu_tanh(av) * bv;
        }
        const size_t tok = (size_t)pm * 256 + (which ? 255 : 0);
        *(u32x2*)(act + tok * DFF + j) = pk4(r);
    }
}
__device__ __forceinline__ void final_phase(const Params& p, int lane, int wave) {
    const int gw = blockIdx.x * 8 + wave, NGW = gridDim.x * 8;
    const float* rowsq2 = (const float*)(p.ws + WS_ROWSQ2); const bf16_t* y2 = (const bf16_t*)(p.ws + WS_XB);
    f32x4 g[4];
#pragma unroll
    for (int j = 0; j < 4; ++j) g[j] = *(const f32x4*)(p.in[I_GFPOST] + 4 * (lane + 64 * j));
    for (int tok = gw; tok < M; tok += NGW) {
        f32x4* orow = (f32x4*)(p.out + (size_t)tok * D) + lane; const u32x2* yr = (const u32x2*)(y2 + (size_t)tok * D) + lane;
        const float rstd = rsqrtf(rowsq2[tok] * (1.0f / D) + EPS);
#pragma unroll
        for (int j = 0; j < 4; ++j) { const f32x4 yv = unpk4(yr[64 * j]); orow[64 * j] = orow[64 * j] + yv * rstd * g[j]; }
    }
}

constexpr int NPHASE = 14;
#ifndef PHMASK
#define PHMASK 0x3fff
#endif
typedef const __attribute__((address_space(4))) Params* KArgs;
__device__ __forceinline__ Params load_params(KArgs q) { Params p;
#pragma unroll
    for (int i = 0; i < 25; ++i) p.in[i] = q->in[i];
    p.out = q->out; p.ws = q->ws; p.ph_lo = q->ph_lo; p.ph_hi = q->ph_hi; return p; }
#define PHASE_ARGS() KArgs q_ = kp; asm volatile("" : "+s"(q_)); const Params p = load_params(q_); unsigned char* ws = p.ws; unsigned char* ob = (unsigned char*)p.out; bf16_t* xb = (bf16_t*)(ws + WS_XB); (void)ob; (void)xb
__global__ void __launch_bounds__(512, 2) fwd_kernel(Params parg) {
    extern __shared__ __attribute__((aligned(16))) unsigned char lds_raw[];
    LAS unsigned char* lds = (LAS unsigned char*)lds_raw;
    const int tid = threadIdx.x, lane = tid & 63, wave = __builtin_amdgcn_readfirstlane(tid >> 6);
    const int G = gridDim.x, blk = blockIdx.x;
    KArgs kp = (KArgs)__builtin_amdgcn_kernarg_segment_ptr();
    const int ph_lo = kp->ph_lo, ph_hi = kp->ph_hi;
    cg::grid_group grid = cg::this_grid();
#ifndef REPMASK
#define REPMASK 0
#endif
#define IN(k) (((PHMASK >> (k)) & 1) && ph_lo <= (k) && (k) < ph_hi)
#define REPS(k) for (int rep_ = 0; rep_ <= ((REPMASK >> (k)) & 1); ++rep_, (((REPMASK >> (k)) & 1) && rep_ == 1 ? grid.sync() : (void)0))
#define SEAM(k) do { if (ph_lo <= (k) && (k) + 1 < ph_hi) grid.sync(); } while (0)

    if (IN(0)) REPS(0) { PHASE_ARGS(); phase0_prep(p, lds, tid, lane, wave); } SEAM(0);
    if (IN(1)) REPS(1) { PHASE_ARGS();
        pg8::Gemm g{xb, (const bf16_t*)(ws + WS_WIN1)}; pg8::Order<M / 256, 8, 1> S; S.init(G, blk);
        EpiQKVU E{(bf16_t*)(ws + WS_Q), (bf16_t*)(ws + WS_K), (bf16_t*)(ws + WS_VT), (bf16_t*)(ws + WS_AG)};
        pg8::gemm_phase<1024, 1024, 1024, 0, 0>(lds, g, S, E);
    } SEAM(1);
    if (IN(2)) REPS(2) { PHASE_ARGS();
        attn_phase((const bf16_t*)(ws + WS_Q), (const bf16_t*)(ws + WS_K), (const bf16_t*)(ws + WS_VT), (bf16_t*)(ob + OUT_ATT), p.in[I_RPB], lds, tid, wave, lane);
        __syncthreads();
        pg8::Gemm g{(const bf16_t*)(ws + WS_AG), (const bf16_t*)(ws + WS_PSSM)}; pg8::Order<NCH / 256, 1, NG> S; S.init(G, blk);
        EpiLocal E{(float*)(ob + OUT_L)};
        pg8::gemm_phase<512, KS, 512, (long)NCH * KS, 256L * 512>(lds, g, S, E);
    } SEAM(2);
    if (IN(3)) REPS(3) { PHASE_ARGS(); scan_phase(p, (const float*)(ob + OUT_L), (bf16_t*)(ws + WS_AG), tid); } SEAM(3);
    if (IN(4)) REPS(4) { PHASE_ARGS();
        pg8::Gemm g{(const bf16_t*)(ws + WS_AG), (const bf16_t*)(ws + WS_WSSM)}; pg8::Order<NCH / 256, 2, NG> S; S.init(G, blk);
        EpiSsmOut E{(bf16_t*)(ob + OUT_Y)};
        pg8::gemm_phase<KS, KS, KS, (long)NCH * KS, 512L * KS>(lds, g, S, E);
    } SEAM(4);
    if (IN(5)) REPS(5) { PHASE_ARGS();
        pg8::Gemm g{(const bf16_t*)(ob + OUT_Y), (const bf16_t*)(ws + WS_WGLU)}; pg8::Order<M / 256, 2, 1> S; S.init(G, blk);
        EpiGlu E{(const bf16_t*)(ob + OUT_Y), p.in[I_BGLU], (bf16_t*)(ob + OUT_ATT) + (size_t)M * 512};
        pg8::gemm_phase<512, 512, 512, 0, 0>(lds, g, S, E);
    } SEAM(5);
    if (IN(6)) REPS(6) { PHASE_ARGS();
        pg8::Gemm g{(const bf16_t*)(ob + OUT_ATT), (const bf16_t*)(ws + WS_WBR)}; pg8::Order<M / 256, 4, 2> S; S.init(G, blk);
        EpiT E{(bf16_t*)(ws + WS_T)};
        pg8::gemm_phase<512, 512, 512, (long)M * 512, 1024L * 512>(lds, g, S, E);
    } SEAM(6);
    if (IN(7)) REPS(7) { PHASE_ARGS();
        pg8::Gemm g{xb, (const bf16_t*)(ws + WS_WG)}; pg8::Order<M / 256, 8, 1> S; S.init(G, blk);
        EpiGate E{(bf16_t*)(ws + WS_T)};
        pg8::gemm_phase<1024, 1024, 1024, 0, 0>(lds, g, S, E);
    } SEAM(7);
    if (IN(8)) REPS(8) { PHASE_ARGS();
        pg8::Gemm g{(const bf16_t*)(ws + WS_T), (const bf16_t*)(ws + WS_WOUT)}; pg8::Order<M / 256, 4, 1> S; S.init(G, blk);
        EpiOutF32 E{p.out, (float*)(ws + WS_ROWSQ1)};
        pg8::gemm_phase<1024, 1024, 1024, 0, 0>(lds, g, S, E);
    } SEAM(8);
    if (IN(9)) REPS(9) { PHASE_ARGS(); norm_phase(p, lane, wave); } SEAM(9);
    if (IN(10)) REPS(10) { PHASE_ARGS();
        pg8::Gemm g{xb, (const bf16_t*)(ws + WS_WUP)}; pg8::Order<M / 256, NUP / 256, 1> S; S.init(G, blk);
        EpiUp E{(bf16_t*)(ws + WS_ACT), (bf16_t*)(ws + WS_E), (const float*)(ws + WS_CWT), (LAS float*)(lds + LDS_X)};
        pg8::gemm_phase<1024, 1024, 1024, 0, 0>(lds, g, S, E);
    } SEAM(10);
    if (IN(11)) REPS(11) { PHASE_ARGS(); fixup_phase(p, tid); } SEAM(11);
    if (IN(12)) REPS(12) { PHASE_ARGS();
        pg8::Gemm g{(const bf16_t*)(ws + WS_ACT), (const bf16_t*)(ws + WS_WDOWN)}; pg8::Order<M / 256, 4, 1> S; S.init(G, blk);
        EpiOutBf16 E{xb, (float*)(ws + WS_ROWSQ2)};
        pg8::gemm_phase<DFF, DFF, DFF, 0, 0>(lds, g, S, E);
    } SEAM(12);
    if (IN(13)) REPS(13) { PHASE_ARGS(); final_phase(p, lane, wave); }
#undef IN
#undef SEAM
}

#ifndef N_LAUNCHES
#define N_LAUNCHES 1
#endif
extern "C" void kernel_launch(void* const* d_in, const int* in_sizes, int n_in, void* d_out, int out_size, void* d_ws, size_t ws_size, hipStream_t stream) {
    static int grid = 0;
    if (grid == 0) {
        if (n_in != 25 || out_size != M * D || ws_size < WS_END) { fprintf(stderr, "kernel_launch: unexpected shapes (n_in %d out %d ws %zu)\n", n_in, out_size, ws_size); grid = -1; return; }
        int dev = 0, cus = 0, per_cu = 0;
        hipGetDevice(&dev); hipDeviceGetAttribute(&cus, hipDeviceAttributeMultiprocessorCount, dev);
        hipFuncSetAttribute((const void*)fwd_kernel, hipFuncAttributeMaxDynamicSharedMemorySize, LDS_BYTES);
        hipOccupancyMaxActiveBlocksPerMultiprocessor(&per_cu, (const void*)fwd_kernel, 512, LDS_BYTES);
        (void)hipGetLastError();
        if (per_cu < 1) { fprintf(stderr, "kernel_launch: occupancy query says %d blocks per CU\n", per_cu); per_cu = 1; }
        grid = cus;
    }
    if (grid < 0) return;
    Params p{};
    for (int i = 0; i < 25; ++i) p.in[i] = (const float*)d_in[i];
    p.out = (float*)d_out; p.ws = (unsigned char*)d_ws;
    if (N_LAUNCHES == 1) {
        p.ph_lo = 0; p.ph_hi = NPHASE;
        void* args[] = {&p};
        hipError_t e = hipLaunchCooperativeKernel((const void*)fwd_kernel, dim3(grid), dim3(512), args, LDS_BYTES, stream);
        if (e != hipSuccess) fprintf(stderr, "cooperative launch failed: %s (grid %d)\n", hipGetErrorString(e), grid);
    } else {
        for (int k = 0; k < NPHASE; ++k) {
            p.ph_lo = k; p.ph_hi = k + 1;
            hipLaunchKernelGGL(fwd_kernel, dim3(grid), dim3(512), LDS_BYTES, stream, p);
        }
    }
}
```

```cpp
#include <hip/hip_runtime.h>
#include <hip/hip_cooperative_groups.h>
#include <cstdio>
#include <cstdint>
namespace cg = cooperative_groups;

#define LAS __attribute__((address_space(3)))
typedef unsigned short bf16_t;
typedef short bf16x8 __attribute__((ext_vector_type(8)));
typedef short bf16x4 __attribute__((ext_vector_type(4)));
typedef float f32x4 __attribute__((ext_vector_type(4)));
typedef float f32x2 __attribute__((ext_vector_type(2)));
typedef unsigned u32x4 __attribute__((ext_vector_type(4)));
typedef unsigned u32x2 __attribute__((ext_vector_type(2)));
typedef __bf16 bf2_t __attribute__((ext_vector_type(2)));

constexpr int M = 65536;
constexpr int MP = 32768;
constexpr int D = 1024, DATT = 512, DSSM = 512, NG = 32, DFF = 2816, NUP = 5632;
constexpr int TCH = 32, NCH = M / TCH, KS = 768;
constexpr float EPS = 1e-6f;

constexpr size_t MiB = 1u << 20;
constexpr size_t WS_CTL = 0;
constexpr size_t WS_WUP = 1 * MiB;
constexpr size_t WS_WDOWN = 12 * MiB;
constexpr size_t WS_ROWSQ1 = 17 * MiB + 512 * 1024;
constexpr size_t WS_ROWSQ2 = WS_ROWSQ1 + 256 * 1024;
constexpr size_t WS_CWT = 509 * MiB;
constexpr size_t WS_XB = 18 * MiB;
constexpr size_t WS_BIG = 146 * MiB;
constexpr size_t WS_WIN1 = WS_BIG;
constexpr size_t WS_WG = WS_WIN1 + 4 * MiB;
constexpr size_t WS_WGLU = WS_WG + 4 * MiB;
constexpr size_t WS_WBR = WS_WGLU + 512 * 1024;
constexpr size_t WS_WOUT = WS_WBR + 2 * MiB;
constexpr size_t WS_WSSM = WS_WOUT + 2 * MiB;
constexpr size_t WS_PSSM = WS_WSSM + 24 * MiB;
constexpr size_t WS_Q = 192 * MiB;
constexpr size_t WS_K = 256 * MiB;
constexpr size_t WS_VT = 320 * MiB;
constexpr size_t WS_AG = 384 * MiB;
constexpr size_t WS_T = 192 * MiB;
constexpr size_t WS_ACT = WS_BIG;
constexpr size_t WS_E = 498 * MiB;
constexpr size_t WS_END = 510 * MiB;
static_assert(WS_PSSM + 8 * MiB <= WS_Q, "ws map");
static_assert(WS_AG + 96 * MiB <= WS_E, "ws map");
static_assert(WS_E + (size_t)256 * 4 * NUP * 2 <= WS_CWT, "ws map");
constexpr size_t OUT_ATT = 0, OUT_L = 128 * MiB, OUT_Y = 192 * MiB;

constexpr int LDS_BYTES = 155648;
constexpr int LDS_X = 131072;

__device__ __forceinline__ unsigned pk2(float lo, float hi) { f32x2 v = {lo, hi}; bf2_t b = __builtin_convertvector(v, bf2_t); return __builtin_bit_cast(unsigned, b); }
__device__ __forceinline__ u32x2 pk4(f32x4 v) { u32x2 r; r.x = pk2(v[0], v[1]); r.y = pk2(v[2], v[3]); return r; }
__device__ __forceinline__ float bf2f(unsigned short b) { return __uint_as_float((unsigned)b << 16); }
__device__ __forceinline__ f32x4 unpk4(u32x2 w) { f32x4 r; r[0] = __uint_as_float(w.x << 16); r[1] = __uint_as_float(w.x & 0xffff0000u); r[2] = __uint_as_float(w.y << 16); r[3] = __uint_as_float(w.y & 0xffff0000u); return r; }
__device__ __forceinline__ float sigmoidf_(float x) { return __builtin_amdgcn_rcpf(1.0f + __expf(-x)); }
__device__ __forceinline__ float gelu_tanh(float x) { const float z = 1.5957691216057308f * (x + 0.044715f * x * x * x); return x * sigmoidf_(z); }
__device__ __forceinline__ float wave_sum(float v) {
#pragma unroll
    for (int o = 1; o < 64; o <<= 1) v += __shfl_xor(v, o);
    return v;
}
#define LDS_WAIT() asm volatile("s_waitcnt lgkmcnt(0)" ::: "memory")
template <int CTRL> __device__ __forceinline__ float dpp0(float x) { return __builtin_bit_cast(float, __builtin_amdgcn_update_dpp(0, __builtin_bit_cast(int, x), CTRL, 0xf, 0xf, true)); }
template <int CTRL> __device__ __forceinline__ f32x4 dpp4(f32x4 v) { f32x4 r; r[0] = dpp0<CTRL>(v[0]); r[1] = dpp0<CTRL>(v[1]); r[2] = dpp0<CTRL>(v[2]); r[3] = dpp0<CTRL>(v[3]); return r; }

namespace pg8 {
constexpr int BM = 256, BK = 64, HALF = 128, HTB = HALF * BK * 2, STAGE_BYTES = 8 * HTB, NXCD = 8, WGM = 8;
__host__ __device__ __forceinline__ int lds_byte(int r, int c) { const int st = (r >> 4) * 2 + (c >> 5), rr = r & 15, cc = c & 31, ob = rr * 64 + cc * 2; return st * 1024 + (ob ^ (((ob >> 9) & 1) << 5)); }
__host__ __device__ __forceinline__ void stage_rc(int b, int& R, int& C) { const int st = b / 1024, sb = b % 1024, swz = sb ^ (((sb >> 9) & 1) << 5); R = (st >> 1) * 16 + swz / 64; C = (st & 1) * 32 + (swz % 64) / 2; }

struct Unit { int pm, pn, pb; };
struct Gemm { const bf16_t* A; const bf16_t* Bt; };

template <int nM, int nN, int nB>
struct Order {
    static constexpr int nwg = nM * nN * nB;
    int G, c;
    __device__ void init(int G_, int c_) { G = G_; c = c_; }
    __device__ bool next(int i, Unit& u) const {
        const long L = (long)i * G + c; if (L >= nwg) return false;
        int wgid = (int)L; { constexpr int q = nwg / NXCD, r = nwg % NXCD; const int xcd = wgid % NXCD, off = wgid / NXCD; wgid = (xcd < r ? xcd * (q + 1) : r * (q + 1) + (xcd - r) * q) + off; }
        constexpr int per = nM * nN; u.pb = wgid / per; const int w = wgid % per;
        constexpr int nig = WGM * nN; const int gid = w / nig, fm = gid * WGM, gsz = (nM - fm) < WGM ? (nM - fm) : WGM;
        u.pm = fm + ((w % nig) % gsz); u.pn = (w % nig) / gsz; return true;
    }
};

template <int K, int LDA, int LDB, long SA, long SB, class Sched, class Epi>
__device__ __forceinline__ void gemm_phase(LAS unsigned char* lds, const Gemm g, const Sched& S, const Epi& E) {
    const int tid = threadIdx.x, wid = __builtin_amdgcn_readfirstlane(tid >> 6), lane = tid & 63, wr = wid >> 2, wc = wid & 3, fr = lane & 15, fq = lane >> 4;
    constexpr int nt = K / BK;
    unsigned voffA[2], voffB[2];
#pragma unroll
    for (int i = 0; i < 2; ++i) { int R, C; stage_rc(tid * 16 + i * 8192, R, C); voffA[i] = (unsigned)(R * LDA + C) * 2u; voffB[i] = (unsigned)(R * LDB + C) * 2u; }
    constexpr size_t kstep = (size_t)(BK * 2);
    constexpr size_t hstepA = (size_t)HALF * LDA * 2, hstepB = (size_t)HALF * LDB * 2;
    constexpr size_t tstepA = 2 * hstepA, tstepB = 2 * hstepB;
    const unsigned ldsw = (unsigned)wid * 1024u;
    const int aoff = lds_byte(wr * 64 + fr, fq * 8), boff = lds_byte(wc * 32 + fr, fq * 8);
#define PG8_SA(b, h) (((b) * 2 + (h)) * HTB)
#define PG8_SB(b, h) ((4 + (b) * 2 + (h)) * HTB)
#define PG8_STAGE(bufoff, gbase, voff) do { _Pragma("unroll") for (int _i = 0; _i < 2; ++_i) \
        __builtin_amdgcn_global_load_lds((const unsigned*)((const char*)(gbase) + (voff)[_i]), (LAS unsigned*)(lds + (bufoff) + ldsw + _i * 8192), 16, 0, 0); } while (0)
#define PG8_LDA(dst, b, h) do { _Pragma("unroll") for (int m = 0; m < 4; ++m) _Pragma("unroll") for (int k = 0; k < 2; ++k) dst[m][k] = *(const LAS bf16x8*)(lds + PG8_SA(b, h) + aoff + m * 2048 + k * 1024); } while (0)
#define PG8_LDB(dst, b, h) do { _Pragma("unroll") for (int n = 0; n < 2; ++n) _Pragma("unroll") for (int k = 0; k < 2; ++k) dst[n][k] = *(const LAS bf16x8*)(lds + PG8_SB(b, h) + boff + n * 2048 + k * 1024); } while (0)
#define PG8_MMA(ai, bj, At, Bt) do { __builtin_amdgcn_s_setprio(1); _Pragma("unroll") for (int m = 0; m < 4; ++m) _Pragma("unroll") for (int n = 0; n < 2; ++n) _Pragma("unroll") for (int k = 0; k < 2; ++k) \
        acc[ai][bj][m][n] = __builtin_amdgcn_mfma_f32_16x16x32_bf16(Bt[n][k], At[m][k], acc[ai][bj][m][n], 0, 0, 0); __builtin_amdgcn_s_setprio(0); } while (0)
#define PG8_WAIT_V(n) asm volatile("s_waitcnt vmcnt(" #n ")" ::: "memory")
#define PG8_WAIT_L(n) asm volatile("s_waitcnt lgkmcnt(" #n ")" ::: "memory")
#define PG8_BAR __builtin_amdgcn_s_barrier()
#define PG8_SCHED __builtin_amdgcn_sched_barrier(0)
    Unit cur, nxt; int ui = 0;
    if (!S.next(0, cur)) return;
    f32x4 acc[2][2][4][2];
#pragma unroll
    for (int a = 0; a < 2; ++a)
#pragma unroll
        for (int b = 0; b < 2; ++b)
#pragma unroll
            for (int m = 0; m < 4; ++m)
#pragma unroll
                for (int n = 0; n < 2; ++n) acc[a][b][m][n] = (f32x4){0.f, 0.f, 0.f, 0.f};
    bf16x8 At[4][2], B0[2][2], B1[2][2];
    const char* cA = (const char*)g.A + (size_t)cur.pb * (size_t)(SA * 2) + (size_t)cur.pm * tstepA;
    const char* cB = (const char*)g.Bt + (size_t)cur.pb * (size_t)(SB * 2) + (size_t)cur.pn * tstepB;
    PG8_STAGE(PG8_SB(0, 0), cB, voffB); PG8_STAGE(PG8_SB(0, 1), cB + hstepB, voffB); PG8_STAGE(PG8_SA(0, 0), cA, voffA); PG8_STAGE(PG8_SA(0, 1), cA + hstepA, voffA);
    if (wr == 1) PG8_BAR;
    PG8_WAIT_V(2); PG8_BAR;
    PG8_STAGE(PG8_SB(1, 0), cB + kstep, voffB); PG8_STAGE(PG8_SA(1, 0), cA + kstep, voffA); PG8_STAGE(PG8_SB(1, 1), cB + hstepB + kstep, voffB);
    PG8_WAIT_V(6); PG8_BAR;
    for (;;) {
        const bool has_next = S.next(ui + 1, nxt);
        const char* nA = has_next ? (const char*)g.A + (size_t)nxt.pb * (size_t)(SA * 2) + (size_t)nxt.pm * tstepA : cA;
        const char* nB = has_next ? (const char*)g.Bt + (size_t)nxt.pb * (size_t)(SB * 2) + (size_t)nxt.pn * tstepB : cB;
        for (int t = 0; t < nt; t += 2) {
            const bool last = (t == nt - 2);
            const char* a1 = cA + (size_t)(t + 1) * kstep;
            const char* a2 = last ? nA : cA + (size_t)(t + 2) * kstep; const char* b2 = last ? nB : cB + (size_t)(t + 2) * kstep;
            const char* a3 = a2 + kstep; const char* b3 = b2 + kstep;
            PG8_LDB(B0, 0, 0); PG8_LDB(B1, 0, 1); PG8_SCHED; PG8_LDA(At, 0, 0); PG8_STAGE(PG8_SA(1, 1), a1 + hstepA, voffA);
            PG8_WAIT_V(8); PG8_WAIT_L(0); PG8_BAR; PG8_MMA(0, 0, At, B0); PG8_MMA(0, 1, At, B1); PG8_BAR; PG8_SCHED;
            PG8_LDA(At, 0, 1); PG8_STAGE(PG8_SB(0, 0), b2, voffB); PG8_STAGE(PG8_SB(0, 1), b2 + hstepB, voffB); PG8_STAGE(PG8_SA(0, 0), a2, voffA);
            PG8_WAIT_V(8); PG8_WAIT_L(0); PG8_BAR; PG8_MMA(1, 0, At, B0); PG8_MMA(1, 1, At, B1); PG8_BAR; PG8_SCHED;
            PG8_LDB(B0, 1, 0); PG8_LDB(B1, 1, 1); PG8_SCHED; PG8_LDA(At, 1, 0); PG8_STAGE(PG8_SA(0, 1), a2 + hstepA, voffA);
            PG8_WAIT_V(8); PG8_WAIT_L(0); PG8_BAR; PG8_MMA(0, 0, At, B0); PG8_MMA(0, 1, At, B1); PG8_BAR; PG8_SCHED;
            PG8_LDA(At, 1, 1); PG8_STAGE(PG8_SB(1, 0), b3, voffB); PG8_STAGE(PG8_SB(1, 1), b3 + hstepB, voffB); PG8_STAGE(PG8_SA(1, 0), a3, voffA);
            PG8_WAIT_V(8); PG8_WAIT_L(0); PG8_BAR; PG8_MMA(1, 0, At, B0); PG8_MMA(1, 1, At, B1); PG8_BAR; PG8_SCHED;
        }
        if (wr == 0) PG8_BAR;
        E(acc, cur, wr, wc, fr, fq);
        if (!has_next) break;
#pragma unroll
        for (int a = 0; a < 2; ++a)
#pragma unroll
            for (int b = 0; b < 2; ++b)
#pragma unroll
                for (int m = 0; m < 4; ++m)
#pragma unroll
                    for (int n = 0; n < 2; ++n) acc[a][b][m][n] = (f32x4){0.f, 0.f, 0.f, 0.f};
        cur = nxt; cA = nA; cB = nB; ++ui;
        if (wr == 1) PG8_BAR;
    }
    PG8_WAIT_V(0);
    PG8_BAR;
#undef PG8_SA
#undef PG8_SB
#undef PG8_STAGE
#undef PG8_LDA
#undef PG8_LDB
#undef PG8_MMA
#undef PG8_WAIT_V
#undef PG8_WAIT_L
#undef PG8_BAR
#undef PG8_SCHED
}
}
using pg8::Unit;
typedef f32x4 Acc[2][2][4][2];

#define EPI_ROWS(...) _Pragma("unroll") for (int ai = 0; ai < 2; ++ai) _Pragma("unroll") for (int m = 0; m < 4; ++m) { const int row = u.pm * 256 + ai * 128 + wr * 64 + m * 16 + fr; __VA_ARGS__ }
#define EPI_COLS(...) _Pragma("unroll") for (int bj = 0; bj < 2; ++bj) _Pragma("unroll") for (int n = 0; n < 2; ++n) { const int col = u.pn * 256 + bj * 128 + wc * 32 + n * 16 + fq * 4; const f32x4 v = acc[ai][bj][m][n]; __VA_ARGS__ }

struct EpiQKVU {
    bf16_t *q, *k, *vt, *ag;
    __device__ __forceinline__ void operator()(const Acc& acc, const Unit& u, int wr, int wc, int fr, int fq) const {
        asm volatile("" : "+v"(fr), "+v"(fq));
        const int sel = u.pn >> 1;
        EPI_ROWS(
            const size_t tok = (size_t)row;
            EPI_COLS(
                if (sel == 0) { *(u32x2*)(q + tok * 512 + col) = pk4(v); }
                else if (sel == 1) { *(u32x2*)(k + tok * 512 + (col - 512)) = pk4(v); }
                else if (sel == 2) { *(u32x2*)(vt + tok * 512 + (col - 1024)) = pk4(v); }
                else { const int ch = col - 1536, gg = ch >> 4, hh = ch & 15; const int chunk = row >> 5, ii = row & 31;
                    *(u32x2*)(ag + ((size_t)gg * NCH + chunk) * KS + ii * 16 + hh) = pk4(v); }
            )
        )
    }
};
struct EpiLocal {
    float* L;
    __device__ __forceinline__ void operator()(const Acc& acc, const Unit& u, int wr, int wc, int fr, int fq) const {
        asm volatile("" : "+v"(fr), "+v"(fq));
        EPI_ROWS(
            EPI_COLS( *(f32x4*)(L + ((size_t)row * 32 + u.pb) * 256 + col) = v; )
        )
    }
};
struct EpiSsmOut {
    bf16_t* y;
    __device__ __forceinline__ void operator()(const Acc& acc, const Unit& u, int wr, int wc, int fr, int fq) const {
        asm volatile("" : "+v"(fr), "+v"(fq));
        EPI_ROWS(
            EPI_COLS(
                const int ii = col >> 4, hh = col & 15; const size_t tok = (size_t)row * 32 + ii;
                f32x4 o; o[0] = gelu_tanh(v[0]); o[1] = gelu_tanh(v[1]); o[2] = gelu_tanh(v[2]); o[3] = gelu_tanh(v[3]);
                *(u32x2*)(y + tok * 512 + u.pb * 16 + hh) = pk4(o);
            )
        )
    }
};
struct EpiGlu {
    const bf16_t* y; const float* bglu; bf16_t* o;
    __device__ __forceinline__ void operator()(const Acc& acc, const Unit& u, int wr, int wc, int fr, int fq) const {
        asm volatile("" : "+v"(fr), "+v"(fq));
        EPI_ROWS(
            EPI_COLS(
                const f32x4 yv = unpk4(*(const u32x2*)(y + (size_t)row * 512 + col)); const f32x4 bv = *(const f32x4*)(bglu + col);
                f32x4 r; r[0] = yv[0] * sigmoidf_(v[0] + bv[0]); r[1] = yv[1] * sigmoidf_(v[1] + bv[1]); r[2] = yv[2] * sigmoidf_(v[2] + bv[2]); r[3] = yv[3] * sigmoidf_(v[3] + bv[3]);
                *(u32x2*)(o + (size_t)row * 512 + col) = pk4(r);
            )
        )
    }
};
struct EpiT {
    bf16_t* T;
    __device__ __forceinline__ void operator()(const Acc& acc, const Unit& u, int wr, int wc, int fr, int fq) const {
        asm volatile("" : "+v"(fr), "+v"(fq));
        bf16_t* base = T + (size_t)u.pb * M * 1024;
        EPI_ROWS(
            EPI_COLS( *(u32x2*)(base + (size_t)row * 1024 + col) = pk4(v); )
        )
    }
};
struct EpiGate {
    bf16_t* T;
    __device__ __forceinline__ void operator()(const Acc& acc, const Unit& u, int wr, int wc, int fr, int fq) const {
        asm volatile("" : "+v"(fr), "+v"(fq));
        bf16_t* T1 = T; const bf16_t* T2 = T + (size_t)M * 1024;
        EPI_ROWS(
            _Pragma("unroll")
            for (int n = 0; n < 2; ++n) {
                const int c = u.pn * 128 + wc * 32 + n * 16 + fq * 4;
                const f32x4 ga = acc[ai][0][m][n], gs = acc[ai][1][m][n];
                const f32x4 t1 = unpk4(*(const u32x2*)(T1 + (size_t)row * 1024 + c)), t2 = unpk4(*(const u32x2*)(T2 + (size_t)row * 1024 + c));
                f32x4 r;
                _Pragma("unroll")
                for (int e = 0; e < 4; ++e) r[e] = sigmoidf_(ga[e]) * t1[e] + sigmoidf_(gs[e]) * t2[e];
                *(u32x2*)(T1 + (size_t)row * 1024 + c) = pk4(r);
            }
        )
    }
};
struct EpiOutF32 {
    float* y; float* rowsq;
    __device__ __forceinline__ void operator()(const Acc& acc, const Unit& u, int wr, int wc, int fr, int fq) const {
        asm volatile("" : "+v"(fr), "+v"(fq));
        EPI_ROWS(
            float s = 0.f;
            EPI_COLS( *(f32x4*)(y + (size_t)row * 1024 + col) = v; s += (v[0] * v[0] + v[1] * v[1]) + (v[2] * v[2] + v[3] * v[3]); )
            s += __shfl_xor(s, 16); s += __shfl_xor(s, 32);
            if (fq == 0) atomicAdd(rowsq + row, s);
        )
    }
};
struct EpiOutBf16 {
    bf16_t* y; float* rowsq;
    __device__ __forceinline__ void operator()(const Acc& acc, const Unit& u, int wr, int wc, int fr, int fq) const {
        asm volatile("" : "+v"(fr), "+v"(fq));
        EPI_ROWS(
            float s = 0.f;
            EPI_COLS( *(u32x2*)(y + (size_t)row * 1024 + col) = pk4(v); s += (v[0] * v[0] + v[1] * v[1]) + (v[2] * v[2] + v[3] * v[3]); )
            s += __shfl_xor(s, 16); s += __shfl_xor(s, 32);
            if (fq == 0) atomicAdd(rowsq + row, s);
        )
    }
};
#ifndef EPIUP_SB
#define EPIUP_SB
#endif
struct EpiUp {
    bf16_t* act; bf16_t* E; const float* cwt; LAS float* X;
    __device__ __forceinline__ void operator()(const Acc& acc, const Unit& u, int wr, int wc, int fr, int fq) const {
        asm volatile("" : "+v"(fr), "+v"(fq));
#pragma unroll
        for (int ai = 0; ai < 2; ++ai) {
            const int qrow = 2 * ai + wr;
#pragma unroll
            for (int bj = 0; bj < 2; ++bj)
#pragma unroll
                for (int n = 0; n < 2; ++n) {
                    const int cidx = bj * 128 + wc * 32 + n * 16 + fq * 4;
                    if (fr == 0) *(LAS f32x4*)(X + (2 * qrow + 0) * 256 + cidx) = acc[ai][bj][0][n];
                    if (fr == 15) *(LAS f32x4*)(X + (2 * qrow + 1) * 256 + cidx) = acc[ai][bj][3][n];
                    if (qrow == 0 && fr < 2) *(u32x2*)(E + ((size_t)u.pm * 4 + fr) * NUP + u.pn * 256 + cidx) = pk4(acc[ai][bj][0][n]);
                    if (qrow == 3 && fr >= 14) *(u32x2*)(E + ((size_t)u.pm * 4 + (fr - 12)) * NUP + u.pn * 256 + cidx) = pk4(acc[ai][bj][3][n]);
                }
        }
        asm volatile("s_waitcnt lgkmcnt(0)" ::: "memory"); __builtin_amdgcn_s_barrier(); asm volatile("" ::: "memory");
        const float first = fr == 0 ? 1.f : 0.f, lastf = fr == 15 ? 1.f : 0.f;
#pragma unroll
        for (int n = 0; n < 2; ++n) {
            const int ca = wc * 32 + n * 16 + fq * 4;
            const int j = u.pn * 128 + ca;
            const f32x4* wt = (const f32x4*)(cwt + (size_t)(j >> 2) * 32);
            const f32x4 wa0 = wt[0], wa1 = wt[1], wa2 = wt[2], ba = wt[3], wb0 = wt[4], wb1 = wt[5], wb2 = wt[6], bb = wt[7];
#pragma unroll
            for (int ai = 0; ai < 2; ++ai) {
                const int qrow = 2 * ai + wr;
                const int sp = qrow > 0 ? 2 * (qrow - 1) + 1 : 0, sn = qrow < 3 ? 2 * (qrow + 1) : 0;
                const float fp = qrow > 0 ? first : 0.f, fn = qrow < 3 ? lastf : 0.f;
#pragma unroll
                for (int m = 0; m < 4; ++m) {
                    const f32x4 a_c = acc[ai][0][m][n], b_c = acc[ai][1][m][n];
                    f32x4 a_p = dpp4<0x111>(a_c), b_p = dpp4<0x111>(b_c), a_n = dpp4<0x101>(a_c), b_n = dpp4<0x101>(b_c);
                    if (m > 0) { a_p += dpp4<0x10F>(acc[ai][0][m > 0 ? m - 1 : 0][n]); b_p += dpp4<0x10F>(acc[ai][1][m > 0 ? m - 1 : 0][n]); }
                    else { a_p += *(const LAS f32x4*)(X + sp * 256 + ca) * fp; b_p += *(const LAS f32x4*)(X + sp * 256 + 128 + ca) * fp; }
                    if (m < 3) { a_n += dpp4<0x11F>(acc[ai][0][m < 3 ? m + 1 : 3][n]); b_n += dpp4<0x11F>(acc[ai][1][m < 3 ? m + 1 : 3][n]); }
                    else { a_n += *(const LAS f32x4*)(X + sn * 256 + ca) * fn; b_n += *(const LAS f32x4*)(X + sn * 256 + 128 + ca) * fn; }
                    const int rt = ai * 128 + wr * 64 + m * 16 + fr;
                    f32x4 r;
#pragma unroll
                    for (int e = 0; e < 4; ++e) {
                        const float av = wa0[e] * a_p[e] + wa1[e] * a_c[e] + wa2[e] * a_n[e] + ba[e];
                        const float bv = wb0[e] * b_p[e] + wb1[e] * b_c[e] + wb2[e] * b_n[e] + bb[e];
                        r[e] = gelu_tanh(av) * bv;
                    }
                    if (rt != 0 && rt != 255) *(u32x2*)(act + ((size_t)u.pm * 256 + rt) * DFF + j) = pk4(r);
                    EPIUP_SB;
                }
            }
        }
    }
};

struct Params { const float* in[25]; float* out; unsigned char* ws; int ph_lo, ph_hi; };
enum { I_XP = 0, I_XS, I_GMPRE, I_GMPOST, I_WIN, I_RPB, I_LRE, I_LIM, I_LDT, I_BRE, I_BIM, I_CRE, I_CIM, I_SD, I_WGLU, I_BGLU, I_WBA, I_WBS, I_WOUT, I_GFPRE, I_GFPOST, I_WUP, I_CW, I_CB, I_WDOWN };

__device__ __forceinline__ const float* xrow_ptr(const Params& p, int tok) { return tok < MP ? p.in[I_XP] + (size_t)tok * D : p.in[I_XS] + (size_t)(tok - MP) * D; }

__device__ __forceinline__ void transpose_item(const float* W, int ldw, int K, int srccol0, bf16_t* WT, int destrow0, float scale, LAS float* scr, int kb, int lane) {
    const int k0 = 64 * kb;
#pragma unroll 8
    for (int i = 0; i < 32; ++i) { const int kk = 2 * i + (lane >> 5); scr[kk * 33 + (lane & 31)] = W[(size_t)(k0 + kk) * ldw + srccol0 + (lane & 31)]; }
    LDS_WAIT(); asm volatile("" ::: "memory");
    const int c = lane & 7;
#pragma unroll
    for (int j = 0; j < 4; ++j) { const int n = (lane >> 3) + 8 * j; const LAS float* s = scr + (8 * c) * 33 + n;
        u32x4 o; o.x = pk2(s[0 * 33] * scale, s[1 * 33] * scale); o.y = pk2(s[2 * 33] * scale, s[3 * 33] * scale); o.z = pk2(s[4 * 33] * scale, s[5 * 33] * scale); o.w = pk2(s[6 * 33] * scale, s[7 * 33] * scale);
        *(u32x4*)(WT + (size_t)(destrow0 + n) * K + k0 + 8 * c) = o; }
    LDS_WAIT(); asm volatile("" ::: "memory");
}

struct cplx { float x, y; };
__device__ __forceinline__ cplx cmul(cplx a, cplx b) { return {a.x * b.x - a.y * b.y, a.x * b.y + a.y * b.x}; }
__device__ __forceinline__ cplx cexp_scaled(float lre, float lim, float s) { const float mag = expf(lre * s); float sn, cs; sincosf(lim * s, &sn, &cs); return {mag * cs, mag * sn}; }
__device__ __forceinline__ cplx zoh_coef(float lre, float lim, float dt) {
    const cplx lb = cexp_scaled(lre, lim, dt); const float nx = lb.x - 1.0f, ny = lb.y; const float inv = 1.0f / (lre * lre + lim * lim);
    return {(nx * lre + ny * lim) * inv, (ny * lre - nx * lim) * inv};
}

__device__ __forceinline__ void phase0_prep(const Params& p, LAS unsigned char* lds, int tid, int lane, int wave) {
    unsigned char* ws = p.ws;
    const int G = gridDim.x, blk = blockIdx.x;
    const int gw = blk * 8 + wave, NGW = G * 8;
    const int gt = blk * 512 + tid, NGT = G * 512;
    { float* z = (float*)(ws + WS_ROWSQ1); for (int i = gt; i < 2 * M; i += NGT) z[i] = 0.f; }
    { float* t = (float*)(ws + WS_CWT); const float* cw = p.in[I_CW]; const float* cb = p.in[I_CB];
      for (int i = gt; i < (DFF / 4) * 32; i += NGT) { const int e = i & 3, k = (i >> 2) & 7, j = (i >> 5) * 4 + e; const int col = (k >= 4 ? DFF : 0) + j; const int kk = k & 3;
          t[i] = kk < 3 ? cw[kk * NUP + col] : cb[col]; } }
    {
        bf16_t* xb = (bf16_t*)(ws + WS_XB); const float* gp = p.in[I_GMPRE];
        f32x4 gv[4];
#pragma unroll
        for (int j = 0; j < 4; ++j) gv[j] = *(const f32x4*)(gp + 4 * (lane + 64 * j));
        for (int tok = gw; tok < M; tok += NGW) {
            const f32x4* xr = (const f32x4*)xrow_ptr(p, tok) + lane;
            f32x4 v[4]; float s = 0.f;
#pragma unroll
            for (int j = 0; j < 4; ++j) { v[j] = xr[64 * j]; s += (v[j][0] * v[j][0] + v[j][1] * v[j][1]) + (v[j][2] * v[j][2] + v[j][3] * v[j][3]); }
            const float rstd = rsqrtf(wave_sum(s) * (1.0f / D) + EPS);
            u32x2* o = (u32x2*)(xb + (size_t)tok * D) + lane;
#pragma unroll
            for (int j = 0; j < 4; ++j) { f32x4 r = v[j] * rstd * gv[j]; o[64 * j] = pk4(r); }
        }
    }
    {
        LAS float* scr = (LAS float*)(lds + wave * 16384);
        constexpr int I0 = 16 * 64;
        constexpr int I1 = 16 * 64;
        constexpr int I2 = 8 * 16;
        constexpr int I3 = 8 * 32;
        constexpr int I4 = 8 * 32;
        constexpr int I5 = 16 * 32;
        constexpr int I6 = 16 * 176;
        constexpr int I7 = 44 * 32;
        constexpr int NIT = I0 + I1 + I2 + I3 + I4 + I5 + I6 + I7;
        for (int it = gw; it < NIT; it += NGW) {
            int r = it;
            if (r < I0) { const int nb = r % 64, kb = r / 64, n0 = nb * 32; transpose_item(p.in[I_WIN], 4096, 1024, n0, (bf16_t*)(ws + WS_WIN1), n0, n0 < 512 ? 0.125f : 1.0f, scr, kb, lane); continue; } r -= I0;
            if (r < I1) { const int nb = r % 64, kb = r / 64, n0 = nb * 32; const int src = 2048 + ((n0 >> 7) & 1) * 1024 + (n0 >> 8) * 128 + (n0 & 127);
                          transpose_item(p.in[I_WIN], 4096, 1024, src, (bf16_t*)(ws + WS_WG), n0, 1.0f, scr, kb, lane); continue; } r -= I1;
            if (r < I2) { const int nb = r % 16, kb = r / 16, n0 = nb * 32; transpose_item(p.in[I_WGLU], 512, 512, n0, (bf16_t*)(ws + WS_WGLU), n0, 1.0f, scr, kb, lane); continue; } r -= I2;
            if (r < I3) { const int nb = r % 32, kb = r / 32, n0 = nb * 32; transpose_item(p.in[I_WBA], 1024, 512, n0, (bf16_t*)(ws + WS_WBR), n0, 1.0f, scr, kb, lane); continue; } r -= I3;
            if (r < I4) { const int nb = r % 32, kb = r / 32, n0 = nb * 32; transpose_item(p.in[I_WBS], 1024, 512, n0, (bf16_t*)(ws + WS_WBR) + (size_t)1024 * 512, n0, 1.0f, scr, kb, lane); continue; } r -= I4;
            if (r < I5) { const int nb = r % 32, kb = r / 32, n0 = nb * 32; transpose_item(p.in[I_WOUT], 1024, 1024, n0, (bf16_t*)(ws + WS_WOUT), n0, 1.0f, scr, kb, lane); continue; } r -= I5;
            if (r < I6) { const int nb = r % 176, kb = r / 176, n0 = nb * 32; const int src = ((n0 >> 7) & 1) * DFF + (n0 >> 8) * 128 + (n0 & 127);
                          transpose_item(p.in[I_WUP], NUP, 1024, src, (bf16_t*)(ws + WS_WUP), n0, 1.0f, scr, kb, lane); continue; } r -= I6;
            { const int nb = r % 32, kb = r / 32, n0 = nb * 32; transpose_item(p.in[I_WDOWN], 1024, DFF, n0, (bf16_t*)(ws + WS_WDOWN), n0, 1.0f, scr, kb, lane); }
        }
    }
    __syncthreads();
    const float* lre = p.in[I_LRE]; const float* lim = p.in[I_LIM]; const float* ldt = p.in[I_LDT];
    const float* bre = p.in[I_BRE]; const float* bim = p.in[I_BIM]; const float* cre = p.in[I_CRE]; const float* cim = p.in[I_CIM];
    bf16_t* Wssm = (bf16_t*)(ws + WS_WSSM); bf16_t* Pssm = (bf16_t*)(ws + WS_PSSM);
    LAS f32x2* PW = (LAS f32x2*)lds;
    LAS f32x2* CF = (LAS f32x2*)(lds + 33792);
    LAS f32x2* BB = (LAS f32x2*)(lds + 50176);
    LAS f32x2* CO = (LAS f32x2*)(lds + 66560);
    for (int item = blk; item < 256; item += G) {
        const int g = item & 31, sub = item >> 5;
        __syncthreads();
        for (int idx = tid; idx < 2 * 33 * 64; idx += 512) {
            const int dir = idx / (33 * 64), e = (idx >> 6) % 33, pp = idx & 63;
            const float a = lre[(dir * NG + g) * 64 + pp], b = lim[(dir * NG + g) * 64 + pp], dt = expf(ldt[dir * NG + g]);
            const cplx v = cexp_scaled(a, b, dt * (float)e); PW[idx] = (f32x2){v.x, v.y};
        }
        if (tid < 128) { const int dir = tid >> 6, pp = tid & 63;
            const float a = lre[(dir * NG + g) * 64 + pp], b = lim[(dir * NG + g) * 64 + pp], dt = expf(ldt[dir * NG + g]);
            const cplx v = zoh_coef(a, b, dt); CO[tid] = (f32x2){v.x, v.y}; }
        for (int idx = tid; idx < 2048; idx += 512) { const int dir = idx >> 10; CF[idx] = (f32x2){cre[(dir * NG + g) * 1024 + (idx & 1023)], cim[(dir * NG + g) * 1024 + (idx & 1023)]}; }
        __syncthreads();
        for (int idx = tid; idx < 2048; idx += 512) { const int dir = idx >> 10, pp = (idx >> 4) & 63;
            const f32x2 co = CO[dir * 64 + pp]; const cplx bq = {bre[(dir * NG + g) * 1024 + (idx & 1023)], bim[(dir * NG + g) * 1024 + (idx & 1023)]};
            const cplx v = cmul({co.x, co.y}, bq); BB[idx] = (f32x2){v.x, v.y}; }
        __syncthreads();
        {
            const int h = (tid >> 4) & 15, hp = tid & 15;
            for (int j = 0; j < 4; ++j) {
                const int dd = sub + 8 * (2 * j + (tid >> 8));
                if (dd < 63) {
                    const int d = dd - 31, e = d < 0 ? -d : d; float accv = 0.f;
                    if (d >= 0) {
#pragma unroll 8
                        for (int pp = 0; pp < 64; ++pp) { const f32x2 F = PW[e * 64 + pp], c = CF[h * 64 + pp], bq = BB[pp * 16 + hp];
                            const float cfx = c.x * F.x - c.y * F.y, cfy = c.x * F.y + c.y * F.x; accv += cfx * bq.x - cfy * bq.y; }
                    }
                    if (d <= 0) {
#pragma unroll 8
                        for (int pp = 0; pp < 64; ++pp) { const f32x2 F = PW[(33 + e) * 64 + pp], c = CF[1024 + h * 64 + pp], bq = BB[1024 + pp * 16 + hp];
                            const float cfx = c.x * F.x - c.y * F.y, cfy = c.x * F.y + c.y * F.x; accv += cfx * bq.x - cfy * bq.y; }
                    }
                    if (d == 0 && h == hp) accv += p.in[I_SD][16 * g + h];
                    const bf16_t w = (bf16_t)(pk2(accv, 0.f) & 0xffffu);
                    const int i0 = d > 0 ? d : 0, i1 = d < 0 ? 31 + d : 31;
                    for (int i = i0; i <= i1; ++i) { const int sidx = i - d; Wssm[((size_t)g * 512 + i * 16 + h) * KS + sidx * 16 + hp] = w; }
                }
            }
        }
        for (int k = 0; k < 16; ++k) {
            const int idx = sub * 8192 + k * 512 + tid;
            const int pp = idx & 63, dir = (idx >> 6) & 1, h = (idx >> 7) & 15, i = (idx >> 11) & 31;
            const int e = dir == 0 ? i + 1 : 32 - i;
            const f32x2 c = CF[dir * 1024 + h * 64 + pp], F = PW[(dir * 33 + e) * 64 + pp];
            const float clx = c.x * F.x - c.y * F.y, cly = c.x * F.y + c.y * F.x;
            bf16_t* dst = Wssm + ((size_t)g * 512 + i * 16 + h) * KS + 512 + dir * 128 + pp;
            dst[0] = (bf16_t)(pk2(clx, 0.f) & 0xffffu); dst[64] = (bf16_t)(pk2(-cly, 0.f) & 0xffffu);
        }
        for (int k = 0; k < 16; ++k) {
            const int idx = sub * 8192 + k * 512 + tid;
            const int hp = idx & 15, sidx = (idx >> 4) & 31, pp = (idx >> 9) & 63, dir = (idx >> 15) & 1;
            const int e = dir == 0 ? 31 - sidx : sidx;
            const f32x2 F = PW[(dir * 33 + e) * 64 + pp], bq = BB[dir * 1024 + pp * 16 + hp];
            const float vx = F.x * bq.x - F.y * bq.y, vy = F.x * bq.y + F.y * bq.x;
            bf16_t* dst = Pssm + ((size_t)g * 256 + dir * 128 + pp) * 512 + sidx * 16 + hp;
            dst[0] = (bf16_t)(pk2(vx, 0.f) & 0xffffu); dst[(size_t)64 * 512] = (bf16_t)(pk2(vy, 0.f) & 0xffffu);
        }
    }
    __syncthreads();
}

typedef short v4i16_t __attribute__((ext_vector_type(4)));
constexpr int ATT_K = 0, ATT_V = 73728, ATT_RPB = 147456;
__device__ __forceinline__ u32x2 vtr(LAS unsigned char* p) { return __builtin_bit_cast(u32x2, __builtin_amdgcn_ds_read_tr16_b64_v4i16((LAS v4i16_t*)p)); }
__device__ __forceinline__ void attn_phase(const bf16_t* __restrict__ qb, const bf16_t* __restrict__ kb, const bf16_t* __restrict__ vb, bf16_t* __restrict__ att, const float* __restrict__ rpb,
                                           LAS unsigned char* lds, int tid, int wave, int lane) {
    const int G = gridDim.x;
    const int qi = lane & 15, q4 = lane >> 4, n = wave & 3, half = wave >> 2;
    const int c = 16 * n + qi;
    int cs = c - 8; cs = cs < 0 ? 0 : (cs > 48 ? 48 : cs);
    int bs = 16 * n - 8; bs = bs < 0 ? 0 : (bs > 32 ? 32 : bs);
    const int kswz = ((bs >> 1) + (qi >> 1)) & 7;
    const int koff0 = (bs + qi) * 128, kx0 = (q4 ^ kswz) << 4, kx1 = ((4 + q4) ^ kswz) << 4;
    const int vtok = bs + 4 * q4 + (qi >> 2), vsw = (vtok >> 1) & 3;
    const int voff0 = vtok * 128 + (qi & 3) * 8;
    const int stok = tid >> 3, sc = tid & 7;
    const int skoff = stok * 128 + ((sc ^ ((stok >> 1) & 7)) << 4);
    const int svoff = stok * 128 + (((sc >> 1) ^ ((stok >> 1) & 3)) * 32) + (sc & 1) * 16;
    LAS float* rp = (LAS float*)(lds + ATT_RPB);
    for (int s = blockIdx.x; s < 256; s += G) {
        const int h = s & 7, ss = s >> 3;
        int rows, Rbase, r0;
        if (ss < 16) { rows = 64; Rbase = (ss >> 1) * 64; r0 = (ss & 1) * 32; } else { rows = 32; Rbase = 512 + (ss - 16) * 32; r0 = 0; }
        for (int i = tid; i < 465; i += 512) rp[i] = rpb[h * 465 + i];
#define RSF(r_) ((r_) - 4 < 0 ? 0 : ((r_) - 4 > rows - 8 ? rows - 8 : (r_) - 4))
        const size_t gcol = (size_t)h * 64 + sc * 8;
        {
            const int lo_row = RSF(r0), hi_row = RSF(r0 + 1) + 7;
            for (int kr = lo_row; kr <= hi_row; ++kr) {
                const size_t gofs = ((size_t)(Rbase + kr) * 64 + stok) * 512 + gcol;
                const u32x4 kv = *(const u32x4*)(kb + gofs), vv = *(const u32x4*)(vb + gofs);
                const int slot = (kr % 9) * 8192;
                *(LAS u32x4*)(lds + ATT_K + slot + skoff) = kv; *(LAS u32x4*)(lds + ATT_V + slot + svoff) = vv;
            }
        }
        int loaded_hi = RSF(r0 + 1) + 7;
        const int myr0 = r0 + half;
        bf16x8 qf0, qf1;
        { const size_t tokq = (size_t)(Rbase + myr0) * 64 + c; qf0 = *(const bf16x8*)(qb + tokq * 512 + h * 64 + q4 * 8); qf1 = *(const bf16x8*)(qb + tokq * 512 + h * 64 + 32 + q4 * 8); }
        __syncthreads();
        for (int it = 0; it < 16; ++it) {
            const int r = myr0 + 2 * it;
            int need_hi = loaded_hi;
            if (it < 15) need_hi = RSF(r0 + 2 * (it + 1) + 1) + 7;
            const int npre = need_hi - loaded_hi;
            u32x4 kp0, vp0, kp1, vp1; bf16x8 qn0 = qf0, qn1 = qf1;
            if (npre >= 1) { const size_t gofs = ((size_t)(Rbase + loaded_hi + 1) * 64 + stok) * 512 + gcol; kp0 = *(const u32x4*)(kb + gofs); vp0 = *(const u32x4*)(vb + gofs); }
            if (npre >= 2) { const size_t gofs = ((size_t)(Rbase + loaded_hi + 2) * 64 + stok) * 512 + gcol; kp1 = *(const u32x4*)(kb + gofs); vp1 = *(const u32x4*)(vb + gofs); }
            if (it < 15) { const size_t tokn = (size_t)(Rbase + r + 2) * 64 + c; qn0 = *(const bf16x8*)(qb + tokn * 512 + h * 64 + q4 * 8); qn1 = *(const bf16x8*)(qb + tokn * 512 + h * 64 + 32 + q4 * 8); }
            const int rs = RSF(r);
            const int sb = rs % 9;
            f32x4 st[8][2];
#pragma unroll
            for (int kr = 0; kr < 8; ++kr) {
                int slot = sb + kr; slot = slot >= 9 ? slot - 9 : slot;
                LAS unsigned char* kbase = lds + ATT_K + slot * 8192 + koff0;
#pragma unroll
                for (int hf = 0; hf < 2; ++hf) {
                    const bf16x8 k0 = *(const LAS bf16x8*)(kbase + hf * 2048 + kx0);
                    const bf16x8 k1 = *(const LAS bf16x8*)(kbase + hf * 2048 + kx1);
                    f32x4 a = {0.f, 0.f, 0.f, 0.f};
                    a = __builtin_amdgcn_mfma_f32_16x16x32_bf16(k0, qf0, a, 0, 0, 0);
                    a = __builtin_amdgcn_mfma_f32_16x16x32_bf16(k1, qf1, a, 0, 0, 0);
                    st[kr][hf] = a;
                }
            }
            float mx = -1e30f;
#pragma unroll
            for (int kr = 0; kr < 8; ++kr) {
                const LAS float* brow = rp + (rs + kr - r + 7) * 31;
#pragma unroll
                for (int hf = 0; hf < 2; ++hf)
#pragma unroll
                    for (int e = 0; e < 4; ++e) {
                        const int kc = bs + 16 * hf + 4 * q4 + e; const bool valid = (kc >= cs) && (kc < cs + 16);
                        int dc = kc - c + 15; dc = dc < 0 ? 0 : (dc > 30 ? 30 : dc);
                        const float sv = valid ? st[kr][hf][e] + brow[dc] : -1e30f;
                        st[kr][hf][e] = sv; mx = fmaxf(mx, sv);
                    }
            }
            mx = fmaxf(mx, __shfl_xor(mx, 16)); mx = fmaxf(mx, __shfl_xor(mx, 32));
            float l = 0.f;
#pragma unroll
            for (int kr = 0; kr < 8; ++kr)
#pragma unroll
                for (int hf = 0; hf < 2; ++hf)
#pragma unroll
                    for (int e = 0; e < 4; ++e) { const float pv = __expf(st[kr][hf][e] - mx); st[kr][hf][e] = pv; l += pv; }
            l += __shfl_xor(l, 16); l += __shfl_xor(l, 32);
            f32x4 o[4];
#pragma unroll
            for (int dt = 0; dt < 4; ++dt) o[dt] = (f32x4){0.f, 0.f, 0.f, 0.f};
#pragma unroll
            for (int kr = 0; kr < 8; ++kr) {
                u32x4 pw; pw.x = pk2(st[kr][0][0], st[kr][0][1]); pw.y = pk2(st[kr][0][2], st[kr][0][3]); pw.z = pk2(st[kr][1][0], st[kr][1][1]); pw.w = pk2(st[kr][1][2], st[kr][1][3]);
                const bf16x8 pf = __builtin_bit_cast(bf16x8, pw);
                int slot = sb + kr; slot = slot >= 9 ? slot - 9 : slot;
                LAS unsigned char* vbase = lds + ATT_V + slot * 8192 + voff0;
#pragma unroll
                for (int dt = 0; dt < 4; ++dt) {
                    const u32x2 v0 = vtr(vbase + ((dt ^ vsw) * 32)), v1 = vtr(vbase + 2048 + ((dt ^ vsw) * 32));
                    u32x4 vw; vw.x = v0.x; vw.y = v0.y; vw.z = v1.x; vw.w = v1.y;
                    o[dt] = __builtin_amdgcn_mfma_f32_16x16x32_bf16(__builtin_bit_cast(bf16x8, vw), pf, o[dt], 0, 0, 0);
                }
            }
            const float inv = 1.0f / l;
            const size_t tokq = (size_t)(Rbase + r) * 64 + c;
#pragma unroll
            for (int dt = 0; dt < 4; ++dt) { f32x4 rr = o[dt] * inv; *(u32x2*)(att + tokq * 512 + h * 64 + dt * 16 + 4 * q4) = pk4(rr); }
            __syncthreads();
            if (npre >= 1) { const int slot = ((loaded_hi + 1) % 9) * 8192; *(LAS u32x4*)(lds + ATT_K + slot + skoff) = kp0; *(LAS u32x4*)(lds + ATT_V + slot + svoff) = vp0; }
            if (npre >= 2) { const int slot = ((loaded_hi + 2) % 9) * 8192; *(LAS u32x4*)(lds + ATT_K + slot + skoff) = kp1; *(LAS u32x4*)(lds + ATT_V + slot + svoff) = vp1; }
            loaded_hi = need_hi; qf0 = qn0; qf1 = qn1;
            __syncthreads();
        }
#undef RSF
    }
}

__device__ __forceinline__ void scan_phase(const Params& p, const float* __restrict__ Lb, bf16_t* __restrict__ ag, int tid) {
    const int gt = blockIdx.x * 512 + tid, NGT = gridDim.x * 512;
    for (int idx = gt; idx < 24 * NG * 2 * 64; idx += NGT) {
        const int pp = idx & 63, dir = (idx >> 6) & 1, g = (idx >> 7) & 31, seq = idx >> 12;
        const int nch = seq < 8 ? 128 : 64, ch0 = seq < 8 ? seq * 128 : 1024 + (seq - 8) * 64;
        const float a = p.in[I_LRE][(dir * NG + g) * 64 + pp], b = p.in[I_LIM][(dir * NG + g) * 64 + pp], dt = expf(p.in[I_LDT][dir * NG + g]);
        const cplx lt = cexp_scaled(a, b, dt * (float)TCH);
        float hx = 0.f, hy = 0.f;
        const int colr = dir * 128 + pp;
        for (int c0 = 0; c0 < nch; c0 += 32) {
            float lr[32], li[32];
#pragma unroll
            for (int j = 0; j < 32; ++j) { const int cc = dir == 0 ? c0 + j : nch - 1 - (c0 + j); const float* src = Lb + ((size_t)(ch0 + cc) * 32 + g) * 256 + colr; lr[j] = src[0]; li[j] = src[64]; }
#pragma unroll
            for (int j = 0; j < 32; ++j) {
                const int cc = dir == 0 ? c0 + j : nch - 1 - (c0 + j);
                bf16_t* dst = ag + ((size_t)g * NCH + ch0 + cc) * KS + 512 + colr;
                dst[0] = (bf16_t)(pk2(hx, 0.f) & 0xffffu); dst[64] = (bf16_t)(pk2(hy, 0.f) & 0xffffu);
                const float nx = lt.x * hx - lt.y * hy + lr[j], ny = lt.x * hy + lt.y * hx + li[j];
                hx = nx; hy = ny;
            }
        }
    }
}

__device__ __forceinline__ void norm_phase(const Params& p, int lane, int wave) {
    const int gw = blockIdx.x * 8 + wave, NGW = gridDim.x * 8;
    const float* rowsq1 = (const float*)(p.ws + WS_ROWSQ1); bf16_t* xb = (bf16_t*)(p.ws + WS_XB);
    f32x4 g1[4], g2[4];
#pragma unroll
    for (int j = 0; j < 4; ++j) { g1[j] = *(const f32x4*)(p.in[I_GMPOST] + 4 * (lane + 64 * j)); g2[j] = *(const f32x4*)(p.in[I_GFPRE] + 4 * (lane + 64 * j)); }
    for (int tok = gw; tok < M; tok += NGW) {
        const f32x4* xr = (const f32x4*)xrow_ptr(p, tok) + lane; f32x4* yr = (f32x4*)(p.out + (size_t)tok * D) + lane;
        const float rstd1 = rsqrtf(rowsq1[tok] * (1.0f / D) + EPS);
        f32x4 v[4]; float s = 0.f;
#pragma unroll
        for (int j = 0; j < 4; ++j) { v[j] = xr[64 * j] + yr[64 * j] * rstd1 * g1[j]; s += (v[j][0] * v[j][0] + v[j][1] * v[j][1]) + (v[j][2] * v[j][2] + v[j][3] * v[j][3]); }
        const float rstd2 = rsqrtf(wave_sum(s) * (1.0f / D) + EPS);
        u32x2* o = (u32x2*)(xb + (size_t)tok * D) + lane;
#pragma unroll
        for (int j = 0; j < 4; ++j) { yr[64 * j] = v[j]; f32x4 r = v[j] * rstd2 * g2[j]; o[64 * j] = pk4(r); }
    }
}
__device__ __forceinline__ void fixup_phase(const Params& p, int tid) {
    const int gt = blockIdx.x * 512 + tid, NGT = gridDim.x * 512;
    const bf16_t* E = (const bf16_t*)(p.ws + WS_E); bf16_t* act = (bf16_t*)(p.ws + WS_ACT); const float* cw = p.in[I_CW]; const float* cb = p.in[I_CB];
    for (int idx = gt; idx < 256 * 2 * (DFF / 4); idx += NGT) {
        const int j = (idx % (DFF / 4)) * 4, which = (idx / (DFF / 4)) & 1, pm = idx / (2 * (DFF / 4));
        const bool seq_first = pm < 128 ? (pm % 16 == 0) : ((pm - 128) % 8 == 0), seq_last = pm < 128 ? (pm % 16 == 15) : ((pm - 128) % 8 == 7);
        const int ec = (j >> 7) * 256 + (j & 127);
        const f32x4 z4 = {0.f, 0.f, 0.f, 0.f};
        f32x4 ap, ac, an, bp, bc, bn;
        auto ld = [&](int tile, int slot, int coff) { return unpk4(*(const u32x2*)(E + ((size_t)tile * 4 + slot) * NUP + ec + coff)); };
        if (which == 0) { ac = ld(pm, 0, 0); bc = ld(pm, 0, 128); an = ld(pm, 1, 0); bn = ld(pm, 1, 128);
            if (seq_first) { ap = z4; bp = z4; } else { ap = ld(pm - 1, 3, 0); bp = ld(pm - 1, 3, 128); } }
        else { ap = ld(pm, 2, 0); bp = ld(pm, 2, 128); ac = ld(pm, 3, 0); bc = ld(pm, 3, 128);
            if (seq_last) { an = z4; bn = z4; } else { an = ld(pm + 1, 0, 0); bn = ld(pm + 1, 0, 128); } }
        const f32x4 wa0 = *(const f32x4*)(cw + j), wa1 = *(const f32x4*)(cw + NUP + j), wa2 = *(const f32x4*)(cw + 2 * NUP + j), ba = *(const f32x4*)(cb + j);
        const f32x4 wb0 = *(const f32x4*)(cw + DFF + j), wb1 = *(const f32x4*)(cw + NUP + DFF + j), wb2 = *(const f32x4*)(cw + 2 * NUP + DFF + j), bb = *(const f32x4*)(cb + DFF + j);
        f32x4 r;
#pragma unroll
        for (int e = 0; e < 4; ++e) {
            const float av = wa0[e] * ap[e] + wa1[e] * ac[e] + wa2[e] * an[e] + ba[e];
            const float bv = wb0[e] * bp[e] + wb1[e] * bc[e] + wb2[e] * bn[e] + bb[e];
            r[e] = gelu_tanh(av) * bv;
        }
        const size_t tok = (size_t)pm * 256 + (which ? 255 : 0);
        *(u32x2*)(act + tok * DFF + j) = pk4(r);
    }
}
__device__ __forceinline__ void final_phase(const Params& p, int lane, int wave) {
    const int gw = blockIdx.x * 8 + wave, NGW = gridDim.x * 8;
    const float* rowsq2 = (const float*)(p.ws + WS_ROWSQ2); const bf16_t* y2 = (const bf16_t*)(p.ws + WS_XB);
    f32x4 g[4];
#pragma unroll
    for (int j = 0; j < 4; ++j) g[j] = *(const f32x4*)(p.in[I_GFPOST] + 4 * (lane + 64 * j));
    for (int tok = gw; tok < M; tok += NGW) {
        f32x4* orow = (f32x4*)(p.out + (size_t)tok * D) + lane; const u32x2* yr = (const u32x2*)(y2 + (size_t)tok * D) + lane;
        const float rstd = rsqrtf(rowsq2[tok] * (1.0f / D) + EPS);
#pragma unroll
        for (int j = 0; j < 4; ++j) { const f32x4 yv = unpk4(yr[64 * j]); orow[64 * j] = orow[64 * j] + yv * rstd * g[j]; }
    }
}

constexpr int NPHASE = 14;
#ifndef PHMASK
#define PHMASK 0x3fff
#endif
typedef const __attribute__((address_space(4))) Params* KArgs;
__device__ __forceinline__ Params load_params(KArgs q) { Params p;
#pragma unroll
    for (int i = 0; i < 25; ++i) p.in[i] = q->in[i];
    p.out = q->out; p.ws = q->ws; p.ph_lo = q->ph_lo; p.ph_hi = q->ph_hi; return p; }
#define PHASE_ARGS() KArgs q_ = kp; asm volatile("" : "+s"(q_)); const Params p = load_params(q_); unsigned char* ws = p.ws; unsigned char* ob = (unsigned char*)p.out; bf16_t* xb = (bf16_t*)(ws + WS_XB); (void)ob; (void)xb
__global__ void __launch_bounds__(512, 2) fwd_kernel(Params parg) {
    extern __shared__ __attribute__((aligned(16))) unsigned char lds_raw[];
    LAS unsigned char* lds = (LAS unsigned char*)lds_raw;
    const int tid = threadIdx.x, lane = tid & 63, wave = __builtin_amdgcn_readfirstlane(tid >> 6);
    const int G = gridDim.x, blk = blockIdx.x;
    KArgs kp = (KArgs)__builtin_amdgcn_kernarg_segment_ptr();
    const int ph_lo = kp->ph_lo, ph_hi = kp->ph_hi;
    cg::grid_group grid = cg::this_grid();
#ifndef REPMASK
#define REPMASK 0
#endif
#define IN(k) (((PHMASK >> (k)) & 1) && ph_lo <= (k) && (k) < ph_hi)
#define REPS(k) for (int rep_ = 0; rep_ <= ((REPMASK >> (k)) & 1); ++rep_, (((REPMASK >> (k)) & 1) && rep_ == 1 ? grid.sync() : (void)0))
#define SEAM(k) do { if (ph_lo <= (k) && (k) + 1 < ph_hi) grid.sync(); } while (0)

    if (IN(0)) REPS(0) { PHASE_ARGS(); phase0_prep(p, lds, tid, lane, wave); } SEAM(0);
    if (IN(1)) REPS(1) { PHASE_ARGS();
        pg8::Gemm g{xb, (const bf16_t*)(ws + WS_WIN1)}; pg8::Order<M / 256, 8, 1> S; S.init(G, blk);
        EpiQKVU E{(bf16_t*)(ws + WS_Q), (bf16_t*)(ws + WS_K), (bf16_t*)(ws + WS_VT), (bf16_t*)(ws + WS_AG)};
        pg8::gemm_phase<1024, 1024, 1024, 0, 0>(lds, g, S, E);
    } SEAM(1);
    if (IN(2)) REPS(2) { PHASE_ARGS();
        attn_phase((const bf16_t*)(ws + WS_Q), (const bf16_t*)(ws + WS_K), (const bf16_t*)(ws + WS_VT), (bf16_t*)(ob + OUT_ATT), p.in[I_RPB], lds, tid, wave, lane);
        __syncthreads();
        pg8::Gemm g{(const bf16_t*)(ws + WS_AG), (const bf16_t*)(ws + WS_PSSM)}; pg8::Order<NCH / 256, 1, NG> S; S.init(G, blk);
        EpiLocal E{(float*)(ob + OUT_L)};
        pg8::gemm_phase<512, KS, 512, (long)NCH * KS, 256L * 512>(lds, g, S, E);
    } SEAM(2);
    if (IN(3)) REPS(3) { PHASE_ARGS(); scan_phase(p, (const float*)(ob + OUT_L), (bf16_t*)(ws + WS_AG), tid); } SEAM(3);
    if (IN(4)) REPS(4) { PHASE_ARGS();
        pg8::Gemm g{(const bf16_t*)(ws + WS_AG), (const bf16_t*)(ws + WS_WSSM)}; pg8::Order<NCH / 256, 2, NG> S; S.init(G, blk);
        EpiSsmOut E{(bf16_t*)(ob + OUT_Y)};
        pg8::gemm_phase<KS, KS, KS, (long)NCH * KS, 512L * KS>(lds, g, S, E);
    } SEAM(4);
    if (IN(5)) REPS(5) { PHASE_ARGS();
        pg8::Gemm g{(const bf16_t*)(ob + OUT_Y), (const bf16_t*)(ws + WS_WGLU)}; pg8::Order<M / 256, 2, 1> S; S.init(G, blk);
        EpiGlu E{(const bf16_t*)(ob + OUT_Y), p.in[I_BGLU], (bf16_t*)(ob + OUT_ATT) + (size_t)M * 512};
        pg8::gemm_phase<512, 512, 512, 0, 0>(lds, g, S, E);
    } SEAM(5);
    if (IN(6)) REPS(6) { PHASE_ARGS();
        pg8::Gemm g{(const bf16_t*)(ob + OUT_ATT), (const bf16_t*)(ws + WS_WBR)}; pg8::Order<M / 256, 4, 2> S; S.init(G, blk);
        EpiT E{(bf16_t*)(ws + WS_T)};
        pg8::gemm_phase<512, 512, 512, (long)M * 512, 1024L * 512>(lds, g, S, E);
    } SEAM(6);
    if (IN(7)) REPS(7) { PHASE_ARGS();
        pg8::Gemm g{xb, (const bf16_t*)(ws + WS_WG)}; pg8::Order<M / 256, 8, 1> S; S.init(G, blk);
        EpiGate E{(bf16_t*)(ws + WS_T)};
        pg8::gemm_phase<1024, 1024, 1024, 0, 0>(lds, g, S, E);
    } SEAM(7);
    if (IN(8)) REPS(8) { PHASE_ARGS();
        pg8::Gemm g{(const bf16_t*)(ws + WS_T), (const bf16_t*)(ws + WS_WOUT)}; pg8::Order<M / 256, 4, 1> S; S.init(G, blk);
        EpiOutF32 E{p.out, (float*)(ws + WS_ROWSQ1)};
        pg8::gemm_phase<1024, 1024, 1024, 0, 0>(lds, g, S, E);
    } SEAM(8);
    if (IN(9)) REPS(9) { PHASE_ARGS(); norm_phase(p, lane, wave); } SEAM(9);
    if (IN(10)) REPS(10) { PHASE_ARGS();
        pg8::Gemm g{xb, (const bf16_t*)(ws + WS_WUP)}; pg8::Order<M / 256, NUP / 256, 1> S; S.init(G, blk);
        EpiUp E{(bf16_t*)(ws + WS_ACT), (bf16_t*)(ws + WS_E), (const float*)(ws + WS_CWT), (LAS float*)(lds + LDS_X)};
        pg8::gemm_phase<1024, 1024, 1024, 0, 0>(lds, g, S, E);
    } SEAM(10);
    if (IN(11)) REPS(11) { PHASE_ARGS(); fixup_phase(p, tid); } SEAM(11);
    if (IN(12)) REPS(12) { PHASE_ARGS();
        pg8::Gemm g{(const bf16_t*)(ws + WS_ACT), (const bf16_t*)(ws + WS_WDOWN)}; pg8::Order<M / 256, 4, 1> S; S.init(G, blk);
        EpiOutBf16 E{xb, (float*)(ws + WS_ROWSQ2)};
        pg8::gemm_phase<DFF, DFF, DFF, 0, 0>(lds, g, S, E);
    } SEAM(12);
    if (IN(13)) REPS(13) { PHASE_ARGS(); final_phase(p, lane, wave); }
#undef IN
#undef SEAM
}

#ifndef N_LAUNCHES
#define N_LAUNCHES 1
#endif
extern "C" void kernel_launch(void* const* d_in, const int* in_sizes, int n_in, void* d_out, int out_size, void* d_ws, size_t ws_size, hipStream_t stream) {
    static int grid = 0;
    if (grid == 0) {
        if (n_in != 25 || out_size != M * D || ws_size < WS_END) { fprintf(stderr, "kernel_launch: unexpected shapes (n_in %d out %d ws %zu)\n", n_in, out_size, ws_size); grid = -1; return; }
        int dev = 0, cus = 0, per_cu = 0;
        hipGetDevice(&dev); hipDeviceGetAttribute(&cus, hipDeviceAttributeMultiprocessorCount, dev);
        hipFuncSetAttribute((const void*)fwd_kernel, hipFuncAttributeMaxDynamicSharedMemorySize, LDS_BYTES);
        hipOccupancyMaxActiveBlocksPerMultiprocessor(&per_cu, (const void*)fwd_kernel, 512, LDS_BYTES);
        (void)hipGetLastError();
        if (per_cu < 1) { fprintf(stderr, "kernel_launch: occupancy query says %d blocks per CU\n", per_cu); per_cu = 1; }
        grid = cus;
    }
    if (grid < 0) return;
    Params p{};
    for (int i = 0; i < 25; ++i) p.in[i] = (const float*)d_in[i];
    p.out = (float*)d_out; p.ws = (unsigned char*)d_ws;
    if (N_LAUNCHES == 1) {
        p.ph_lo = 0; p.ph_hi = NPHASE;
        void* args[] = {&p};
        hipError_t e = hipLaunchCooperativeKernel((const void*)fwd_kernel, dim3(grid), dim3(512), args, LDS_BYTES, stream);
        if (e != hipSuccess) fprintf(stderr, "cooperative launch failed: %s (grid %d)\n", hipGetErrorString(e), grid);
    } else {
        for (int k = 0; k < NPHASE; ++k) {
            p.ph_lo = k; p.ph_hi = k + 1;
            hipLaunchKernelGGL(fwd_kernel, dim3(grid), dim3(512), LDS_BYTES, stream, p);
        }
    }
}
```

```cpp
#include <hip/hip_runtime.h>
#include <hip/hip_cooperative_groups.h>
#include <cstdio>
#include <cstdint>
namespace cg = cooperative_groups;

#define LAS __attribute__((address_space(3)))
typedef unsigned short bf16_t;
typedef short bf16x8 __attribute__((ext_vector_type(8)));
typedef short bf16x4 __attribute__((ext_vector_type(4)));
typedef float f32x4 __attribute__((ext_vector_type(4)));
typedef float f32x2 __attribute__((ext_vector_type(2)));
typedef unsigned u32x4 __attribute__((ext_vector_type(4)));
typedef unsigned u32x2 __attribute__((ext_vector_type(2)));
typedef __bf16 bf2_t __attribute__((ext_vector_type(2)));

constexpr int M = 65536;
constexpr int MP = 32768;
constexpr int D = 1024, DATT = 512, DSSM = 512, NG = 32, DFF = 2816, NUP = 5632;
constexpr int TCH = 32, NCH = M / TCH, KS = 768;
constexpr float EPS = 1e-6f;

constexpr size_t MiB = 1u << 20;
constexpr size_t WS_CTL = 0;
constexpr size_t WS_WUP = 1 * MiB;
constexpr size_t WS_WDOWN = 12 * MiB;
constexpr size_t WS_ROWSQ1 = 17 * MiB + 512 * 1024;
constexpr size_t WS_ROWSQ2 = WS_ROWSQ1 + 256 * 1024;
constexpr size_t WS_CWT = 509 * MiB;
constexpr size_t WS_XB = 18 * MiB;
constexpr size_t WS_BIG = 146 * MiB;
constexpr size_t WS_WIN1 = WS_BIG;
constexpr size_t WS_WG = WS_WIN1 + 4 * MiB;
constexpr size_t WS_WGLU = WS_WG + 4 * MiB;
constexpr size_t WS_WBR = WS_WGLU + 512 * 1024;
constexpr size_t WS_WOUT = WS_WBR + 2 * MiB;
constexpr size_t WS_WSSM = WS_WOUT + 2 * MiB;
constexpr size_t WS_PSSM = WS_WSSM + 24 * MiB;
constexpr size_t WS_Q = 192 * MiB;
constexpr size_t WS_K = 256 * MiB;
constexpr size_t WS_VT = 320 * MiB;
constexpr size_t WS_AG = 384 * MiB;
constexpr size_t WS_T = 192 * MiB;
constexpr size_t WS_ACT = WS_BIG;
constexpr size_t WS_E = 498 * MiB;
constexpr size_t WS_END = 510 * MiB;
static_assert(WS_PSSM + 8 * MiB <= WS_Q, "ws map");
static_assert(WS_AG + 96 * MiB <= WS_E, "ws map");
static_assert(WS_E + (size_t)256 * 4 * NUP * 2 <= WS_CWT, "ws map");
constexpr size_t OUT_ATT = 0, OUT_L = 128 * MiB, OUT_Y = 192 * MiB;

constexpr int LDS_BYTES = 155648;
constexpr int LDS_BAR = 155136;
constexpr int LDS_X = 131072;

__device__ __forceinline__ unsigned pk2(float lo, float hi) { f32x2 v = {lo, hi}; bf2_t b = __builtin_convertvector(v, bf2_t); return __builtin_bit_cast(unsigned, b); }
__device__ __forceinline__ u32x2 pk4(f32x4 v) { u32x2 r; r.x = pk2(v[0], v[1]); r.y = pk2(v[2], v[3]); return r; }
__device__ __forceinline__ float bf2f(unsigned short b) { return __uint_as_float((unsigned)b << 16); }
__device__ __forceinline__ f32x4 unpk4(u32x2 w) { f32x4 r; r[0] = __uint_as_float(w.x << 16); r[1] = __uint_as_float(w.x & 0xffff0000u); r[2] = __uint_as_float(w.y << 16); r[3] = __uint_as_float(w.y & 0xffff0000u); return r; }
__device__ __forceinline__ float sigmoidf_(float x) { return __builtin_amdgcn_rcpf(1.0f + __expf(-x)); }
__device__ __forceinline__ float gelu_tanh(float x) { const float z = 1.5957691216057308f * (x + 0.044715f * x * x * x); return x * sigmoidf_(z); }
__device__ __forceinline__ float wave_sum(float v) {
#pragma unroll
    for (int o = 1; o < 64; o <<= 1) v += __shfl_xor(v, o);
    return v;
}
#define LDS_WAIT() asm volatile("s_waitcnt lgkmcnt(0)" ::: "memory")
template <int CTRL> __device__ __forceinline__ float dpp0(float x) { return __builtin_bit_cast(float, __builtin_amdgcn_update_dpp(0, __builtin_bit_cast(int, x), CTRL, 0xf, 0xf, true)); }
template <int CTRL> __device__ __forceinline__ f32x4 dpp4(f32x4 v) { f32x4 r; r[0] = dpp0<CTRL>(v[0]); r[1] = dpp0<CTRL>(v[1]); r[2] = dpp0<CTRL>(v[2]); r[3] = dpp0<CTRL>(v[3]); return r; }

namespace pg8 {
constexpr int BM = 256, BK = 64, HALF = 128, HTB = HALF * BK * 2, STAGE_BYTES = 8 * HTB, NXCD = 8, WGM = 8;
__host__ __device__ __forceinline__ int lds_byte(int r, int c) { const int st = (r >> 4) * 2 + (c >> 5), rr = r & 15, cc = c & 31, ob = rr * 64 + cc * 2; return st * 1024 + (ob ^ (((ob >> 9) & 1) << 5)); }
__host__ __device__ __forceinline__ void stage_rc(int b, int& R, int& C) { const int st = b / 1024, sb = b % 1024, swz = sb ^ (((sb >> 9) & 1) << 5); R = (st >> 1) * 16 + swz / 64; C = (st & 1) * 32 + (swz % 64) / 2; }

struct Unit { int pm, pn, pb; };
struct Gemm { const bf16_t* A; const bf16_t* Bt; };

template <int nM, int nN, int nB>
struct Order {
    static constexpr int nwg = nM * nN * nB;
    int G, c;
    __device__ void init(int G_, int c_) { G = G_; c = c_; }
    __device__ bool next(int i, Unit& u) const {
        const long L = (long)i * G + c; if (L >= nwg) return false;
        int wgid = (int)L; { constexpr int q = nwg / NXCD, r = nwg % NXCD; const int xcd = wgid % NXCD, off = wgid / NXCD; wgid = (xcd < r ? xcd * (q + 1) : r * (q + 1) + (xcd - r) * q) + off; }
        constexpr int per = nM * nN; u.pb = wgid / per; const int w = wgid % per;
        constexpr int nig = WGM * nN; const int gid = w / nig, fm = gid * WGM, gsz = (nM - fm) < WGM ? (nM - fm) : WGM;
        u.pm = fm + ((w % nig) % gsz); u.pn = (w % nig) / gsz; return true;
    }
};

template <int K, int LDA, int LDB, long SA, long SB, class Sched, class Epi>
__device__ __forceinline__ void gemm_phase(LAS unsigned char* lds, const Gemm g, const Sched& S, const Epi& E) {
    const int tid = threadIdx.x, wid = __builtin_amdgcn_readfirstlane(tid >> 6), lane = tid & 63, wr = wid >> 2, wc = wid & 3, fr = lane & 15, fq = lane >> 4;
    constexpr int nt = K / BK;
    unsigned voffA[2], voffB[2];
#pragma unroll
    for (int i = 0; i < 2; ++i) { int R, C; stage_rc(tid * 16 + i * 8192, R, C); voffA[i] = (unsigned)(R * LDA + C) * 2u; voffB[i] = (unsigned)(R * LDB + C) * 2u; }
    constexpr size_t kstep = (size_t)(BK * 2);
    constexpr size_t hstepA = (size_t)HALF * LDA * 2, hstepB = (size_t)HALF * LDB * 2;
    constexpr size_t tstepA = 2 * hstepA, tstepB = 2 * hstepB;
    const unsigned ldsw = (unsigned)wid * 1024u;
    const int aoff = lds_byte(wr * 64 + fr, fq * 8), boff = lds_byte(wc * 32 + fr, fq * 8);
#define PG8_SA(b, h) (((b) * 2 + (h)) * HTB)
#define PG8_SB(b, h) ((4 + (b) * 2 + (h)) * HTB)
#define PG8_STAGE(bufoff, gbase, voff) do { _Pragma("unroll") for (int _i = 0; _i < 2; ++_i) \
        __builtin_amdgcn_global_load_lds((const unsigned*)((const char*)(gbase) + (voff)[_i]), (LAS unsigned*)(lds + (bufoff) + ldsw + _i * 8192), 16, 0, 0); } while (0)
#define PG8_LDA(dst, b, h) do { _Pragma("unroll") for (int m = 0; m < 4; ++m) _Pragma("unroll") for (int k = 0; k < 2; ++k) dst[m][k] = *(const LAS bf16x8*)(lds + PG8_SA(b, h) + aoff + m * 2048 + k * 1024); } while (0)
#define PG8_LDB(dst, b, h) do { _Pragma("unroll") for (int n = 0; n < 2; ++n) _Pragma("unroll") for (int k = 0; k < 2; ++k) dst[n][k] = *(const LAS bf16x8*)(lds + PG8_SB(b, h) + boff + n * 2048 + k * 1024); } while (0)
#define PG8_MMA(ai, bj, At, Bt) do { __builtin_amdgcn_s_setprio(1); _Pragma("unroll") for (int m = 0; m < 4; ++m) _Pragma("unroll") for (int n = 0; n < 2; ++n) _Pragma("unroll") for (int k = 0; k < 2; ++k) \
        acc[ai][bj][m][n] = __builtin_amdgcn_mfma_f32_16x16x32_bf16(Bt[n][k], At[m][k], acc[ai][bj][m][n], 0, 0, 0); __builtin_amdgcn_s_setprio(0); } while (0)
#define PG8_WAIT_V(n) asm volatile("s_waitcnt vmcnt(" #n ")" ::: "memory")
#define PG8_WAIT_L(n) asm volatile("s_waitcnt lgkmcnt(" #n ")" ::: "memory")
#define PG8_BAR __builtin_amdgcn_s_barrier()
#define PG8_SCHED __builtin_amdgcn_sched_barrier(0)
    Unit cur, nxt; int ui = 0;
    if (!S.next(0, cur)) return;
    f32x4 acc[2][2][4][2];
#pragma unroll
    for (int a = 0; a < 2; ++a)
#pragma unroll
        for (int b = 0; b < 2; ++b)
#pragma unroll
            for (int m = 0; m < 4; ++m)
#pragma unroll
                for (int n = 0; n < 2; ++n) acc[a][b][m][n] = (f32x4){0.f, 0.f, 0.f, 0.f};
    bf16x8 At[4][2], B0[2][2], B1[2][2];
    const char* cA = (const char*)g.A + (size_t)cur.pb * (size_t)(SA * 2) + (size_t)cur.pm * tstepA;
    const char* cB = (const char*)g.Bt + (size_t)cur.pb * (size_t)(SB * 2) + (size_t)cur.pn * tstepB;
    PG8_STAGE(PG8_SB(0, 0), cB, voffB); PG8_STAGE(PG8_SB(0, 1), cB + hstepB, voffB); PG8_STAGE(PG8_SA(0, 0), cA, voffA); PG8_STAGE(PG8_SA(0, 1), cA + hstepA, voffA);
    if (wr == 1) PG8_BAR;
    PG8_WAIT_V(2); PG8_BAR;
    PG8_STAGE(PG8_SB(1, 0), cB + kstep, voffB); PG8_STAGE(PG8_SA(1, 0), cA + kstep, voffA); PG8_STAGE(PG8_SB(1, 1), cB + hstepB + kstep, voffB);
    PG8_WAIT_V(6); PG8_BAR;
    for (;;) {
        const bool has_next = S.next(ui + 1, nxt);
        const char* nA = has_next ? (const char*)g.A + (size_t)nxt.pb * (size_t)(SA * 2) + (size_t)nxt.pm * tstepA : cA;
        const char* nB = has_next ? (const char*)g.Bt + (size_t)nxt.pb * (size_t)(SB * 2) + (size_t)nxt.pn * tstepB : cB;
        for (int t = 0; t < nt; t += 2) {
            const bool last = (t == nt - 2);
            const char* a1 = cA + (size_t)(t + 1) * kstep;
            const char* a2 = last ? nA : cA + (size_t)(t + 2) * kstep; const char* b2 = last ? nB : cB + (size_t)(t + 2) * kstep;
            const char* a3 = a2 + kstep; const char* b3 = b2 + kstep;
            PG8_LDB(B0, 0, 0); PG8_LDB(B1, 0, 1); PG8_SCHED; PG8_LDA(At, 0, 0); PG8_STAGE(PG8_SA(1, 1), a1 + hstepA, voffA);
            PG8_WAIT_V(8); PG8_WAIT_L(0); PG8_BAR; PG8_MMA(0, 0, At, B0); PG8_MMA(0, 1, At, B1); PG8_BAR; PG8_SCHED;
            PG8_LDA(At, 0, 1); PG8_STAGE(PG8_SB(0, 0), b2, voffB); PG8_STAGE(PG8_SB(0, 1), b2 + hstepB, voffB); PG8_STAGE(PG8_SA(0, 0), a2, voffA);
            PG8_WAIT_V(8); PG8_WAIT_L(0); PG8_BAR; PG8_MMA(1, 0, At, B0); PG8_MMA(1, 1, At, B1); PG8_BAR; PG8_SCHED;
            PG8_LDB(B0, 1, 0); PG8_LDB(B1, 1, 1); PG8_SCHED; PG8_LDA(At, 1, 0); PG8_STAGE(PG8_SA(0, 1), a2 + hstepA, voffA);
            PG8_WAIT_V(8); PG8_WAIT_L(0); PG8_BAR; PG8_MMA(0, 0, At, B0); PG8_MMA(0, 1, At, B1); PG8_BAR; PG8_SCHED;
            PG8_LDA(At, 1, 1); PG8_STAGE(PG8_SB(1, 0), b3, voffB); PG8_STAGE(PG8_SB(1, 1), b3 + hstepB, voffB); PG8_STAGE(PG8_SA(1, 0), a3, voffA);
            PG8_WAIT_V(8); PG8_WAIT_L(0); PG8_BAR; PG8_MMA(1, 0, At, B0); PG8_MMA(1, 1, At, B1); PG8_BAR; PG8_SCHED;
        }
        if (wr == 0) PG8_BAR;
        E(acc, cur, wr, wc, fr, fq);
        if (!has_next) break;
#pragma unroll
        for (int a = 0; a < 2; ++a)
#pragma unroll
            for (int b = 0; b < 2; ++b)
#pragma unroll
                for (int m = 0; m < 4; ++m)
#pragma unroll
                    for (int n = 0; n < 2; ++n) acc[a][b][m][n] = (f32x4){0.f, 0.f, 0.f, 0.f};
        cur = nxt; cA = nA; cB = nB; ++ui;
        if (wr == 1) PG8_BAR;
    }
    PG8_WAIT_V(0);
    PG8_BAR;
#undef PG8_SA
#undef PG8_SB
#undef PG8_STAGE
#undef PG8_LDA
#undef PG8_LDB
#undef PG8_MMA
#undef PG8_WAIT_V
#undef PG8_WAIT_L
#undef PG8_BAR
#undef PG8_SCHED
}
}
using pg8::Unit;
typedef f32x4 Acc[2][2][4][2];

#define EPI_ROWS(...) _Pragma("unroll") for (int ai = 0; ai < 2; ++ai) _Pragma("unroll") for (int m = 0; m < 4; ++m) { const int row = u.pm * 256 + ai * 128 + wr * 64 + m * 16 + fr; __VA_ARGS__ }
#define EPI_COLS(...) _Pragma("unroll") for (int bj = 0; bj < 2; ++bj) _Pragma("unroll") for (int n = 0; n < 2; ++n) { const int col = u.pn * 256 + bj * 128 + wc * 32 + n * 16 + fq * 4; const f32x4 v = acc[ai][bj][m][n]; __VA_ARGS__ }

struct EpiQKVU {
    bf16_t *q, *k, *vt, *ag;
    __device__ __forceinline__ void operator()(const Acc& acc, const Unit& u, int wr, int wc, int fr, int fq) const {
        asm volatile("" : "+v"(fr), "+v"(fq));
        const int sel = u.pn >> 1;
        EPI_ROWS(
            const size_t tok = (size_t)row;
            EPI_COLS(
                if (sel == 0) { *(u32x2*)(q + tok * 512 + col) = pk4(v); }
                else if (sel == 1) { *(u32x2*)(k + tok * 512 + (col - 512)) = pk4(v); }
                else if (sel == 2) { *(u32x2*)(vt + tok * 512 + (col - 1024)) = pk4(v); }
                else { const int ch = col - 1536, gg = ch >> 4, hh = ch & 15; const int chunk = row >> 5, ii = row & 31;
                    *(u32x2*)(ag + ((size_t)gg * NCH + chunk) * KS + ii * 16 + hh) = pk4(v); }
            )
        )
    }
};
struct EpiLocal {
    float* L;
    __device__ __forceinline__ void operator()(const Acc& acc, const Unit& u, int wr, int wc, int fr, int fq) const {
        asm volatile("" : "+v"(fr), "+v"(fq));
        EPI_ROWS(
            EPI_COLS( *(f32x4*)(L + ((size_t)row * 32 + u.pb) * 256 + col) = v; )
        )
    }
};
struct EpiSsmOut {
    bf16_t* y;
    __device__ __forceinline__ void operator()(const Acc& acc, const Unit& u, int wr, int wc, int fr, int fq) const {
        asm volatile("" : "+v"(fr), "+v"(fq));
        EPI_ROWS(
            EPI_COLS(
                const int ii = col >> 4, hh = col & 15; const size_t tok = (size_t)row * 32 + ii;
                f32x4 o; o[0] = gelu_tanh(v[0]); o[1] = gelu_tanh(v[1]); o[2] = gelu_tanh(v[2]); o[3] = gelu_tanh(v[3]);
                *(u32x2*)(y + tok * 512 + u.pb * 16 + hh) = pk4(o);
            )
        )
    }
};
struct EpiGlu {
    const bf16_t* y; const float* bglu; bf16_t* o;
    __device__ __forceinline__ void operator()(const Acc& acc, const Unit& u, int wr, int wc, int fr, int fq) const {
        asm volatile("" : "+v"(fr), "+v"(fq));
        EPI_ROWS(
            EPI_COLS(
                const f32x4 yv = unpk4(*(const u32x2*)(y + (size_t)row * 512 + col)); const f32x4 bv = *(const f32x4*)(bglu + col);
                f32x4 r; r[0] = yv[0] * sigmoidf_(v[0] + bv[0]); r[1] = yv[1] * sigmoidf_(v[1] + bv[1]); r[2] = yv[2] * sigmoidf_(v[2] + bv[2]); r[3] = yv[3] * sigmoidf_(v[3] + bv[3]);
                *(u32x2*)(o + (size_t)row * 512 + col) = pk4(r);
            )
        )
    }
};
struct EpiT {
    bf16_t* T;
    __device__ __forceinline__ void operator()(const Acc& acc, const Unit& u, int wr, int wc, int fr, int fq) const {
        asm volatile("" : "+v"(fr), "+v"(fq));
        bf16_t* base = T + (size_t)u.pb * M * 1024;
        EPI_ROWS(
            EPI_COLS( *(u32x2*)(base + (size_t)row * 1024 + col) = pk4(v); )
        )
    }
};
struct EpiGate {
    bf16_t* T;
    __device__ __forceinline__ void operator()(const Acc& acc, const Unit& u, int wr, int wc, int fr, int fq) const {
        asm volatile("" : "+v"(fr), "+v"(fq));
        bf16_t* T1 = T; const bf16_t* T2 = T + (size_t)M * 1024;
        EPI_ROWS(
            _Pragma("unroll")
            for (int n = 0; n < 2; ++n) {
                const int c = u.pn * 128 + wc * 32 + n * 16 + fq * 4;
                const f32x4 ga = acc[ai][0][m][n], gs = acc[ai][1][m][n];
                const f32x4 t1 = unpk4(*(const u32x2*)(T1 + (size_t)row * 1024 + c)), t2 = unpk4(*(const u32x2*)(T2 + (size_t)row * 1024 + c));
                f32x4 r;
                _Pragma("unroll")
                for (int e = 0; e < 4; ++e) r[e] = sigmoidf_(ga[e]) * t1[e] + sigmoidf_(gs[e]) * t2[e];
                *(u32x2*)(T1 + (size_t)row * 1024 + c) = pk4(r);
            }
        )
    }
};
struct EpiOutF32 {
    float* y; float* rowsq;
    __device__ __forceinline__ void operator()(const Acc& acc, const Unit& u, int wr, int wc, int fr, int fq) const {
        asm volatile("" : "+v"(fr), "+v"(fq));
        EPI_ROWS(
            float s = 0.f;
            EPI_COLS( *(f32x4*)(y + (size_t)row * 1024 + col) = v; s += (v[0] * v[0] + v[1] * v[1]) + (v[2] * v[2] + v[3] * v[3]); )
            s += __shfl_xor(s, 16); s += __shfl_xor(s, 32);
            if (fq == 0) atomicAdd(rowsq + row, s);
        )
    }
};
struct EpiOutBf16 {
    bf16_t* y; float* rowsq;
    __device__ __forceinline__ void operator()(const Acc& acc, const Unit& u, int wr, int wc, int fr, int fq) const {
        asm volatile("" : "+v"(fr), "+v"(fq));
        EPI_ROWS(
            float s = 0.f;
            EPI_COLS( *(u32x2*)(y + (size_t)row * 1024 + col) = pk4(v); s += (v[0] * v[0] + v[1] * v[1]) + (v[2] * v[2] + v[3] * v[3]); )
            s += __shfl_xor(s, 16); s += __shfl_xor(s, 32);
            if (fq == 0) atomicAdd(rowsq + row, s);
        )
    }
};
#ifndef EPIUP_SB
#define EPIUP_SB
#endif
struct EpiUp {
    bf16_t* act; bf16_t* E; const float* cwt; LAS float* X;
    __device__ __forceinline__ void operator()(const Acc& acc, const Unit& u, int wr, int wc, int fr, int fq) const {
        asm volatile("" : "+v"(fr), "+v"(fq));
#pragma unroll
        for (int ai = 0; ai < 2; ++ai) {
            const int qrow = 2 * ai + wr;
#pragma unroll
            for (int bj = 0; bj < 2; ++bj)
#pragma unroll
                for (int n = 0; n < 2; ++n) {
                    const int cidx = bj * 128 + wc * 32 + n * 16 + fq * 4;
                    if (fr == 0) *(LAS f32x4*)(X + (2 * qrow + 0) * 256 + cidx) = acc[ai][bj][0][n];
                    if (fr == 15) *(LAS f32x4*)(X + (2 * qrow + 1) * 256 + cidx) = acc[ai][bj][3][n];
                    if (qrow == 0 && fr < 2) *(u32x2*)(E + ((size_t)u.pm * 4 + fr) * NUP + u.pn * 256 + cidx) = pk4(acc[ai][bj][0][n]);
                    if (qrow == 3 && fr >= 14) *(u32x2*)(E + ((size_t)u.pm * 4 + (fr - 12)) * NUP + u.pn * 256 + cidx) = pk4(acc[ai][bj][3][n]);
                }
        }
        asm volatile("s_waitcnt lgkmcnt(0)" ::: "memory"); __builtin_amdgcn_s_barrier(); asm volatile("" ::: "memory");
        const float first = fr == 0 ? 1.f : 0.f, lastf = fr == 15 ? 1.f : 0.f;
#pragma unroll
        for (int n = 0; n < 2; ++n) {
            const int ca = wc * 32 + n * 16 + fq * 4;
            const int j = u.pn * 128 + ca;
            const f32x4* wt = (const f32x4*)(cwt + (size_t)(j >> 2) * 32);
            const f32x4 wa0 = wt[0], wa1 = wt[1], wa2 = wt[2], ba = wt[3], wb0 = wt[4], wb1 = wt[5], wb2 = wt[6], bb = wt[7];
#pragma unroll
            for (int ai = 0; ai < 2; ++ai) {
                const int qrow = 2 * ai + wr;
                const int sp = qrow > 0 ? 2 * (qrow - 1) + 1 : 0, sn = qrow < 3 ? 2 * (qrow + 1) : 0;
                const float fp = qrow > 0 ? first : 0.f, fn = qrow < 3 ? lastf : 0.f;
#pragma unroll
                for (int m = 0; m < 4; ++m) {
                    const f32x4 a_c = acc[ai][0][m][n], b_c = acc[ai][1][m][n];
                    f32x4 a_p = dpp4<0x111>(a_c), b_p = dpp4<0x111>(b_c), a_n = dpp4<0x101>(a_c), b_n = dpp4<0x101>(b_c);
                    if (m > 0) { a_p += dpp4<0x10F>(acc[ai][0][m > 0 ? m - 1 : 0][n]); b_p += dpp4<0x10F>(acc[ai][1][m > 0 ? m - 1 : 0][n]); }
                    else { a_p += *(const LAS f32x4*)(X + sp * 256 + ca) * fp; b_p += *(const LAS f32x4*)(X + sp * 256 + 128 + ca) * fp; }
                    if (m < 3) { a_n += dpp4<0x11F>(acc[ai][0][m < 3 ? m + 1 : 3][n]); b_n += dpp4<0x11F>(acc[ai][1][m < 3 ? m + 1 : 3][n]); }
                    else { a_n += *(const LAS f32x4*)(X + sn * 256 + ca) * fn; b_n += *(const LAS f32x4*)(X + sn * 256 + 128 + ca) * fn; }
                    const int rt = ai * 128 + wr * 64 + m * 16 + fr;
                    f32x4 r;
#pragma unroll
                    for (int e = 0; e < 4; ++e) {
                        const float av = wa0[e] * a_p[e] + wa1[e] * a_c[e] + wa2[e] * a_n[e] + ba[e];
                        const float bv = wb0[e] * b_p[e] + wb1[e] * b_c[e] + wb2[e] * b_n[e] + bb[e];
                        r[e] = gelu_tanh(av) * bv;
                    }
                    if (rt != 0 && rt != 255) *(u32x2*)(act + ((size_t)u.pm * 256 + rt) * DFF + j) = pk4(r);
                    EPIUP_SB;
                }
            }
        }
    }
};

struct Params { const float* in[25]; float* out; unsigned char* ws; int ph_lo, ph_hi; };
enum { I_XP = 0, I_XS, I_GMPRE, I_GMPOST, I_WIN, I_RPB, I_LRE, I_LIM, I_LDT, I_BRE, I_BIM, I_CRE, I_CIM, I_SD, I_WGLU, I_BGLU, I_WBA, I_WBS, I_WOUT, I_GFPRE, I_GFPOST, I_WUP, I_CW, I_CB, I_WDOWN };

__device__ __forceinline__ const float* xrow_ptr(const Params& p, int tok) { return tok < MP ? p.in[I_XP] + (size_t)tok * D : p.in[I_XS] + (size_t)(tok - MP) * D; }

__device__ __forceinline__ void transpose_item(const float* W, int ldw, int K, int srccol0, bf16_t* WT, int destrow0, float scale, LAS float* scr, int kb, int lane) {
    const int k0 = 64 * kb;
#pragma unroll 8
    for (int i = 0; i < 32; ++i) { const int kk = 2 * i + (lane >> 5); scr[kk * 33 + (lane & 31)] = W[(size_t)(k0 + kk) * ldw + srccol0 + (lane & 31)]; }
    LDS_WAIT(); asm volatile("" ::: "memory");
    const int c = lane & 7;
#pragma unroll
    for (int j = 0; j < 4; ++j) { const int n = (lane >> 3) + 8 * j; const LAS float* s = scr + (8 * c) * 33 + n;
        u32x4 o; o.x = pk2(s[0 * 33] * scale, s[1 * 33] * scale); o.y = pk2(s[2 * 33] * scale, s[3 * 33] * scale); o.z = pk2(s[4 * 33] * scale, s[5 * 33] * scale); o.w = pk2(s[6 * 33] * scale, s[7 * 33] * scale);
        *(u32x4*)(WT + (size_t)(destrow0 + n) * K + k0 + 8 * c) = o; }
    LDS_WAIT(); asm volatile("" ::: "memory");
}

struct cplx { float x, y; };
__device__ __forceinline__ cplx cmul(cplx a, cplx b) { return {a.x * b.x - a.y * b.y, a.x * b.y + a.y * b.x}; }
__device__ __forceinline__ cplx cexp_scaled(float lre, float lim, float s) { const float mag = expf(lre * s); float sn, cs; sincosf(lim * s, &sn, &cs); return {mag * cs, mag * sn}; }
__device__ __forceinline__ cplx zoh_coef(float lre, float lim, float dt) {
    const cplx lb = cexp_scaled(lre, lim, dt); const float nx = lb.x - 1.0f, ny = lb.y; const float inv = 1.0f / (lre * lre + lim * lim);
    return {(nx * lre + ny * lim) * inv, (ny * lre - nx * lim) * inv};
}

__device__ __forceinline__ void phase0_prep(const Params& p, LAS unsigned char* lds, int tid, int lane, int wave) {
    unsigned char* ws = p.ws;
    const int G = gridDim.x, blk = blockIdx.x;
    const int gw = blk * 8 + wave, NGW = G * 8;
    const int gt = blk * 512 + tid, NGT = G * 512;
    { float* z = (float*)(ws + WS_ROWSQ1); for (int i = gt; i < 2 * M; i += NGT) z[i] = 0.f; }
    { float* t = (float*)(ws + WS_CWT); const float* cw = p.in[I_CW]; const float* cb = p.in[I_CB];
      for (int i = gt; i < (DFF / 4) * 32; i += NGT) { const int e = i & 3, k = (i >> 2) & 7, j = (i >> 5) * 4 + e; const int col = (k >= 4 ? DFF : 0) + j; const int kk = k & 3;
          t[i] = kk < 3 ? cw[kk * NUP + col] : cb[col]; } }
    {
        bf16_t* xb = (bf16_t*)(ws + WS_XB); const float* gp = p.in[I_GMPRE];
        f32x4 gv[4];
#pragma unroll
        for (int j = 0; j < 4; ++j) gv[j] = *(const f32x4*)(gp + 4 * (lane + 64 * j));
        for (int tok = gw; tok < M; tok += NGW) {
            const f32x4* xr = (const f32x4*)xrow_ptr(p, tok) + lane;
            f32x4 v[4]; float s = 0.f;
#pragma unroll
            for (int j = 0; j < 4; ++j) { v[j] = xr[64 * j]; s += (v[j][0] * v[j][0] + v[j][1] * v[j][1]) + (v[j][2] * v[j][2] + v[j][3] * v[j][3]); }
            const float rstd = rsqrtf(wave_sum(s) * (1.0f / D) + EPS);
            u32x2* o = (u32x2*)(xb + (size_t)tok * D) + lane;
#pragma unroll
            for (int j = 0; j < 4; ++j) { f32x4 r = v[j] * rstd * gv[j]; o[64 * j] = pk4(r); }
        }
    }
    {
        LAS float* scr = (LAS float*)(lds + wave * 16384);
        constexpr int I0 = 16 * 64;
        constexpr int I1 = 16 * 64;
        constexpr int I2 = 8 * 16;
        constexpr int I3 = 8 * 32;
        constexpr int I4 = 8 * 32;
        constexpr int I5 = 16 * 32;
        constexpr int I6 = 16 * 176;
        constexpr int I7 = 44 * 32;
        constexpr int NIT = I0 + I1 + I2 + I3 + I4 + I5 + I6 + I7;
        for (int it = gw; it < NIT; it += NGW) {
            int r = it;
            if (r < I0) { const int nb = r % 64, kb = r / 64, n0 = nb * 32; transpose_item(p.in[I_WIN], 4096, 1024, n0, (bf16_t*)(ws + WS_WIN1), n0, n0 < 512 ? 0.125f : 1.0f, scr, kb, lane); continue; } r -= I0;
            if (r < I1) { const int nb = r % 64, kb = r / 64, n0 = nb * 32; const int src = 2048 + ((n0 >> 7) & 1) * 1024 + (n0 >> 8) * 128 + (n0 & 127);
                          transpose_item(p.in[I_WIN], 4096, 1024, src, (bf16_t*)(ws + WS_WG), n0, 1.0f, scr, kb, lane); continue; } r -= I1;
            if (r < I2) { const int nb = r % 16, kb = r / 16, n0 = nb * 32; transpose_item(p.in[I_WGLU], 512, 512, n0, (bf16_t*)(ws + WS_WGLU), n0, 1.0f, scr, kb, lane); continue; } r -= I2;
            if (r < I3) { const int nb = r % 32, kb = r / 32, n0 = nb * 32; transpose_item(p.in[I_WBA], 1024, 512, n0, (bf16_t*)(ws + WS_WBR), n0, 1.0f, scr, kb, lane); continue; } r -= I3;
            if (r < I4) { const int nb = r % 32, kb = r / 32, n0 = nb * 32; transpose_item(p.in[I_WBS], 1024, 512, n0, (bf16_t*)(ws + WS_WBR) + (size_t)1024 * 512, n0, 1.0f, scr, kb, lane); continue; } r -= I4;
            if (r < I5) { const int nb = r % 32, kb = r / 32, n0 = nb * 32; transpose_item(p.in[I_WOUT], 1024, 1024, n0, (bf16_t*)(ws + WS_WOUT), n0, 1.0f, scr, kb, lane); continue; } r -= I5;
            if (r < I6) { const int nb = r % 176, kb = r / 176, n0 = nb * 32; const int src = ((n0 >> 7) & 1) * DFF + (n0 >> 8) * 128 + (n0 & 127);
                          transpose_item(p.in[I_WUP], NUP, 1024, src, (bf16_t*)(ws + WS_WUP), n0, 1.0f, scr, kb, lane); continue; } r -= I6;
            { const int nb = r % 32, kb = r / 32, n0 = nb * 32; transpose_item(p.in[I_WDOWN], 1024, DFF, n0, (bf16_t*)(ws + WS_WDOWN), n0, 1.0f, scr, kb, lane); }
        }
    }
    __syncthreads();
    const float* lre = p.in[I_LRE]; const float* lim = p.in[I_LIM]; const float* ldt = p.in[I_LDT];
    const float* bre = p.in[I_BRE]; const float* bim = p.in[I_BIM]; const float* cre = p.in[I_CRE]; const float* cim = p.in[I_CIM];
    bf16_t* Wssm = (bf16_t*)(ws + WS_WSSM); bf16_t* Pssm = (bf16_t*)(ws + WS_PSSM);
    LAS f32x2* PW = (LAS f32x2*)lds;
    LAS f32x2* CF = (LAS f32x2*)(lds + 33792);
    LAS f32x2* BB = (LAS f32x2*)(lds + 50176);
    LAS f32x2* CO = (LAS f32x2*)(lds + 66560);
    for (int item = blk; item < 256; item += G) {
        const int g = item & 31, sub = item >> 5;
        __syncthreads();
        for (int idx = tid; idx < 2 * 33 * 64; idx += 512) {
            const int dir = idx / (33 * 64), e = (idx >> 6) % 33, pp = idx & 63;
            const float a = lre[(dir * NG + g) * 64 + pp], b = lim[(dir * NG + g) * 64 + pp], dt = expf(ldt[dir * NG + g]);
            const cplx v = cexp_scaled(a, b, dt * (float)e); PW[idx] = (f32x2){v.x, v.y};
        }
        if (tid < 128) { const int dir = tid >> 6, pp = tid & 63;
            const float a = lre[(dir * NG + g) * 64 + pp], b = lim[(dir * NG + g) * 64 + pp], dt = expf(ldt[dir * NG + g]);
            const cplx v = zoh_coef(a, b, dt); CO[tid] = (f32x2){v.x, v.y}; }
        for (int idx = tid; idx < 2048; idx += 512) { const int dir = idx >> 10; CF[idx] = (f32x2){cre[(dir * NG + g) * 1024 + (idx & 1023)], cim[(dir * NG + g) * 1024 + (idx & 1023)]}; }
        __syncthreads();
        for (int idx = tid; idx < 2048; idx += 512) { const int dir = idx >> 10, pp = (idx >> 4) & 63;
            const f32x2 co = CO[dir * 64 + pp]; const cplx bq = {bre[(dir * NG + g) * 1024 + (idx & 1023)], bim[(dir * NG + g) * 1024 + (idx & 1023)]};
            const cplx v = cmul({co.x, co.y}, bq); BB[idx] = (f32x2){v.x, v.y}; }
        __syncthreads();
        {
            const int h = (tid >> 4) & 15, hp = tid & 15;
            for (int j = 0; j < 4; ++j) {
                const int dd = sub + 8 * (2 * j + (tid >> 8));
                if (dd < 63) {
                    const int d = dd - 31, e = d < 0 ? -d : d; float accv = 0.f;
                    if (d >= 0) {
#pragma unroll 8
                        for (int pp = 0; pp < 64; ++pp) { const f32x2 F = PW[e * 64 + pp], c = CF[h * 64 + pp], bq = BB[pp * 16 + hp];
                            const float cfx = c.x * F.x - c.y * F.y, cfy = c.x * F.y + c.y * F.x; accv += cfx * bq.x - cfy * bq.y; }
                    }
                    if (d <= 0) {
#pragma unroll 8
                        for (int pp = 0; pp < 64; ++pp) { const f32x2 F = PW[(33 + e) * 64 + pp], c = CF[1024 + h * 64 + pp], bq = BB[1024 + pp * 16 + hp];
                            const float cfx = c.x * F.x - c.y * F.y, cfy = c.x * F.y + c.y * F.x; accv += cfx * bq.x - cfy * bq.y; }
                    }
                    if (d == 0 && h == hp) accv += p.in[I_SD][16 * g + h];
                    const bf16_t w = (bf16_t)(pk2(accv, 0.f) & 0xffffu);
                    const int i0 = d > 0 ? d : 0, i1 = d < 0 ? 31 + d : 31;
                    for (int i = i0; i <= i1; ++i) { const int sidx = i - d; Wssm[((size_t)g * 512 + i * 16 + h) * KS + sidx * 16 + hp] = w; }
                }
            }
        }
        for (int k = 0; k < 16; ++k) {
            const int idx = sub * 8192 + k * 512 + tid;
            const int pp = idx & 63, dir = (idx >> 6) & 1, h = (idx >> 7) & 15, i = (idx >> 11) & 31;
            const int e = dir == 0 ? i + 1 : 32 - i;
            const f32x2 c = CF[dir * 1024 + h * 64 + pp], F = PW[(dir * 33 + e) * 64 + pp];
            const float clx = c.x * F.x - c.y * F.y, cly = c.x * F.y + c.y * F.x;
            bf16_t* dst = Wssm + ((size_t)g * 512 + i * 16 + h) * KS + 512 + dir * 128 + pp;
            dst[0] = (bf16_t)(pk2(clx, 0.f) & 0xffffu); dst[64] = (bf16_t)(pk2(-cly, 0.f) & 0xffffu);
        }
        for (int k = 0; k < 16; ++k) {
            const int idx = sub * 8192 + k * 512 + tid;
            const int hp = idx & 15, sidx = (idx >> 4) & 31, pp = (idx >> 9) & 63, dir = (idx >> 15) & 1;
            const int e = dir == 0 ? 31 - sidx : sidx;
            const f32x2 F = PW[(dir * 33 + e) * 64 + pp], bq = BB[dir * 1024 + pp * 16 + hp];
            const float vx = F.x * bq.x - F.y * bq.y, vy = F.x * bq.y + F.y * bq.x;
            bf16_t* dst = Pssm + ((size_t)g * 256 + dir * 128 + pp) * 512 + sidx * 16 + hp;
            dst[0] = (bf16_t)(pk2(vx, 0.f) & 0xffffu); dst[(size_t)64 * 512] = (bf16_t)(pk2(vy, 0.f) & 0xffffu);
        }
    }
    __syncthreads();
}

typedef short v4i16_t __attribute__((ext_vector_type(4)));
constexpr int ATT_K = 0, ATT_V = 73728, ATT_RPB = 147456;
__device__ __forceinline__ u32x2 vtr(LAS unsigned char* p) { return __builtin_bit_cast(u32x2, __builtin_amdgcn_ds_read_tr16_b64_v4i16((LAS v4i16_t*)p)); }
__device__ __forceinline__ void attn_phase(const bf16_t* __restrict__ qb, const bf16_t* __restrict__ kb, const bf16_t* __restrict__ vb, bf16_t* __restrict__ att, const float* __restrict__ rpb,
                                           LAS unsigned char* lds, int tid, int wave, int lane) {
    const int G = gridDim.x;
    const int qi = lane & 15, q4 = lane >> 4, n = wave & 3, half = wave >> 2;
    const int c = 16 * n + qi;
    int cs = c - 8; cs = cs < 0 ? 0 : (cs > 48 ? 48 : cs);
    int bs = 16 * n - 8; bs = bs < 0 ? 0 : (bs > 32 ? 32 : bs);
    const int kswz = ((bs >> 1) + (qi >> 1)) & 7;
    const int koff0 = (bs + qi) * 128, kx0 = (q4 ^ kswz) << 4, kx1 = ((4 + q4) ^ kswz) << 4;
    const int vtok = bs + 4 * q4 + (qi >> 2), vsw = (vtok >> 1) & 3;
    const int voff0 = vtok * 128 + (qi & 3) * 8;
    const int stok = tid >> 3, sc = tid & 7;
    const int skoff = stok * 128 + ((sc ^ ((stok >> 1) & 7)) << 4);
    const int svoff = stok * 128 + (((sc >> 1) ^ ((stok >> 1) & 3)) * 32) + (sc & 1) * 16;
    LAS float* rp = (LAS float*)(lds + ATT_RPB);
    for (int s = blockIdx.x; s < 256; s += G) {
        const int h = s & 7, ss = s >> 3;
        int rows, Rbase, r0;
        if (ss < 16) { rows = 64; Rbase = (ss >> 1) * 64; r0 = (ss & 1) * 32; } else { rows = 32; Rbase = 512 + (ss - 16) * 32; r0 = 0; }
        for (int i = tid; i < 465; i += 512) rp[i] = rpb[h * 465 + i];
#define RSF(r_) ((r_) - 4 < 0 ? 0 : ((r_) - 4 > rows - 8 ? rows - 8 : (r_) - 4))
        const size_t gcol = (size_t)h * 64 + sc * 8;
        {
            const int lo_row = RSF(r0), hi_row = RSF(r0 + 1) + 7;
            for (int kr = lo_row; kr <= hi_row; ++kr) {
                const size_t gofs = ((size_t)(Rbase + kr) * 64 + stok) * 512 + gcol;
                const u32x4 kv = *(const u32x4*)(kb + gofs), vv = *(const u32x4*)(vb + gofs);
                const int slot = (kr % 9) * 8192;
                *(LAS u32x4*)(lds + ATT_K + slot + skoff) = kv; *(LAS u32x4*)(lds + ATT_V + slot + svoff) = vv;
            }
        }
        int loaded_hi = RSF(r0 + 1) + 7;
        const int myr0 = r0 + half;
        bf16x8 qf0, qf1;
        { const size_t tokq = (size_t)(Rbase + myr0) * 64 + c; qf0 = *(const bf16x8*)(qb + tokq * 512 + h * 64 + q4 * 8); qf1 = *(const bf16x8*)(qb + tokq * 512 + h * 64 + 32 + q4 * 8); }
        __syncthreads();
        for (int it = 0; it < 16; ++it) {
            const int r = myr0 + 2 * it;
            int need_hi = loaded_hi;
            if (it < 15) need_hi = RSF(r0 + 2 * (it + 1) + 1) + 7;
            const int npre = need_hi - loaded_hi;
            u32x4 kp0, vp0, kp1, vp1; bf16x8 qn0 = qf0, qn1 = qf1;
            if (npre >= 1) { const size_t gofs = ((size_t)(Rbase + loaded_hi + 1) * 64 + stok) * 512 + gcol; kp0 = *(const u32x4*)(kb + gofs); vp0 = *(const u32x4*)(vb + gofs); }
            if (npre >= 2) { const size_t gofs = ((size_t)(Rbase + loaded_hi + 2) * 64 + stok) * 512 + gcol; kp1 = *(const u32x4*)(kb + gofs); vp1 = *(const u32x4*)(vb + gofs); }
            if (it < 15) { const size_t tokn = (size_t)(Rbase + r + 2) * 64 + c; qn0 = *(const bf16x8*)(qb + tokn * 512 + h * 64 + q4 * 8); qn1 = *(const bf16x8*)(qb + tokn * 512 + h * 64 + 32 + q4 * 8); }
            const int rs = RSF(r);
            const int sb = rs % 9;
            f32x4 st[8][2];
#pragma unroll
            for (int kr = 0; kr < 8; ++kr) {
                int slot = sb + kr; slot = slot >= 9 ? slot - 9 : slot;
                LAS unsigned char* kbase = lds + ATT_K + slot * 8192 + koff0;
#pragma unroll
                for (int hf = 0; hf < 2; ++hf) {
                    const bf16x8 k0 = *(const LAS bf16x8*)(kbase + hf * 2048 + kx0);
                    const bf16x8 k1 = *(const LAS bf16x8*)(kbase + hf * 2048 + kx1);
                    f32x4 a = {0.f, 0.f, 0.f, 0.f};
                    a = __builtin_amdgcn_mfma_f32_16x16x32_bf16(k0, qf0, a, 0, 0, 0);
                    a = __builtin_amdgcn_mfma_f32_16x16x32_bf16(k1, qf1, a, 0, 0, 0);
                    st[kr][hf] = a;
                }
            }
            float mx = -1e30f;
#pragma unroll
            for (int kr = 0; kr < 8; ++kr) {
                const LAS float* brow = rp + (rs + kr - r + 7) * 31;
#pragma unroll
                for (int hf = 0; hf < 2; ++hf)
#pragma unroll
                    for (int e = 0; e < 4; ++e) {
                        const int kc = bs + 16 * hf + 4 * q4 + e; const bool valid = (kc >= cs) && (kc < cs + 16);
                        int dc = kc - c + 15; dc = dc < 0 ? 0 : (dc > 30 ? 30 : dc);
                        const float sv = valid ? st[kr][hf][e] + brow[dc] : -1e30f;
                        st[kr][hf][e] = sv; mx = fmaxf(mx, sv);
                    }
            }
            mx = fmaxf(mx, __shfl_xor(mx, 16)); mx = fmaxf(mx, __shfl_xor(mx, 32));
            float l = 0.f;
#pragma unroll
            for (int kr = 0; kr < 8; ++kr)
#pragma unroll
                for (int hf = 0; hf < 2; ++hf)
#pragma unroll
                    for (int e = 0; e < 4; ++e) { const float pv = __expf(st[kr][hf][e] - mx); st[kr][hf][e] = pv; l += pv; }
            l += __shfl_xor(l, 16); l += __shfl_xor(l, 32);
            f32x4 o[4];
#pragma unroll
            for (int dt = 0; dt < 4; ++dt) o[dt] = (f32x4){0.f, 0.f, 0.f, 0.f};
#pragma unroll
            for (int kr = 0; kr < 8; ++kr) {
                u32x4 pw; pw.x = pk2(st[kr][0][0], st[kr][0][1]); pw.y = pk2(st[kr][0][2], st[kr][0][3]); pw.z = pk2(st[kr][1][0], st[kr][1][1]); pw.w = pk2(st[kr][1][2], st[kr][1][3]);
                const bf16x8 pf = __builtin_bit_cast(bf16x8, pw);
                int slot = sb + kr; slot = slot >= 9 ? slot - 9 : slot;
                LAS unsigned char* vbase = lds + ATT_V + slot * 8192 + voff0;
#pragma unroll
                for (int dt = 0; dt < 4; ++dt) {
                    const u32x2 v0 = vtr(vbase + ((dt ^ vsw) * 32)), v1 = vtr(vbase + 2048 + ((dt ^ vsw) * 32));
                    u32x4 vw; vw.x = v0.x; vw.y = v0.y; vw.z = v1.x; vw.w = v1.y;
                    o[dt] = __builtin_amdgcn_mfma_f32_16x16x32_bf16(__builtin_bit_cast(bf16x8, vw), pf, o[dt], 0, 0, 0);
                }
            }
            const float inv = 1.0f / l;
            const size_t tokq = (size_t)(Rbase + r) * 64 + c;
#pragma unroll
            for (int dt = 0; dt < 4; ++dt) { f32x4 rr = o[dt] * inv; *(u32x2*)(att + tokq * 512 + h * 64 + dt * 16 + 4 * q4) = pk4(rr); }
            __syncthreads();
            if (npre >= 1) { const int slot = ((loaded_hi + 1) % 9) * 8192; *(LAS u32x4*)(lds + ATT_K + slot + skoff) = kp0; *(LAS u32x4*)(lds + ATT_V + slot + svoff) = vp0; }
            if (npre >= 2) { const int slot = ((loaded_hi + 2) % 9) * 8192; *(LAS u32x4*)(lds + ATT_K + slot + skoff) = kp1; *(LAS u32x4*)(lds + ATT_V + slot + svoff) = vp1; }
            loaded_hi = need_hi; qf0 = qn0; qf1 = qn1;
            __syncthreads();
        }
#undef RSF
    }
}

__device__ __forceinline__ void scan_phase(const Params& p, const float* __restrict__ Lb, bf16_t* __restrict__ ag, int tid) {
    const int gt = blockIdx.x * 512 + tid, NGT = gridDim.x * 512;
    for (int idx = gt; idx < 24 * NG * 2 * 64; idx += NGT) {
        const int pp = idx & 63, dir = (idx >> 6) & 1, g = (idx >> 7) & 31, seq = idx >> 12;
        const int nch = seq < 8 ? 128 : 64, ch0 = seq < 8 ? seq * 128 : 1024 + (seq - 8) * 64;
        const float a = p.in[I_LRE][(dir * NG + g) * 64 + pp], b = p.in[I_LIM][(dir * NG + g) * 64 + pp], dt = expf(p.in[I_LDT][dir * NG + g]);
        const cplx lt = cexp_scaled(a, b, dt * (float)TCH);
        float hx = 0.f, hy = 0.f;
        const int colr = dir * 128 + pp;
        for (int c0 = 0; c0 < nch; c0 += 32) {
            float lr[32], li[32];
#pragma unroll
            for (int j = 0; j < 32; ++j) { const int cc = dir == 0 ? c0 + j : nch - 1 - (c0 + j); const float* src = Lb + ((size_t)(ch0 + cc) * 32 + g) * 256 + colr; lr[j] = src[0]; li[j] = src[64]; }
#pragma unroll
            for (int j = 0; j < 32; ++j) {
                const int cc = dir == 0 ? c0 + j : nch - 1 - (c0 + j);
                bf16_t* dst = ag + ((size_t)g * NCH + ch0 + cc) * KS + 512 + colr;
                dst[0] = (bf16_t)(pk2(hx, 0.f) & 0xffffu); dst[64] = (bf16_t)(pk2(hy, 0.f) & 0xffffu);
                const float nx = lt.x * hx - lt.y * hy + lr[j], ny = lt.x * hy + lt.y * hx + li[j];
                hx = nx; hy = ny;
            }
        }
    }
}

__device__ __forceinline__ void norm_phase(const Params& p, int lane, int wave) {
    const int gw = blockIdx.x * 8 + wave, NGW = gridDim.x * 8;
    const float* rowsq1 = (const float*)(p.ws + WS_ROWSQ1); bf16_t* xb = (bf16_t*)(p.ws + WS_XB);
    f32x4 g1[4], g2[4];
#pragma unroll
    for (int j = 0; j < 4; ++j) { g1[j] = *(const f32x4*)(p.in[I_GMPOST] + 4 * (lane + 64 * j)); g2[j] = *(const f32x4*)(p.in[I_GFPRE] + 4 * (lane + 64 * j)); }
    for (int tok = gw; tok < M; tok += NGW) {
        const f32x4* xr = (const f32x4*)xrow_ptr(p, tok) + lane; f32x4* yr = (f32x4*)(p.out + (size_t)tok * D) + lane;
        const float rstd1 = rsqrtf(rowsq1[tok] * (1.0f / D) + EPS);
        f32x4 v[4]; float s = 0.f;
#pragma unroll
        for (int j = 0; j < 4; ++j) { v[j] = xr[64 * j] + yr[64 * j] * rstd1 * g1[j]; s += (v[j][0] * v[j][0] + v[j][1] * v[j][1]) + (v[j][2] * v[j][2] + v[j][3] * v[j][3]); }
        const float rstd2 = rsqrtf(wave_sum(s) * (1.0f / D) + EPS);
        u32x2* o = (u32x2*)(xb + (size_t)tok * D) + lane;
#pragma unroll
        for (int j = 0; j < 4; ++j) { yr[64 * j] = v[j]; f32x4 r = v[j] * rstd2 * g2[j]; o[64 * j] = pk4(r); }
    }
}
__device__ __forceinline__ void fixup_phase(const Params& p, int tid) {
    const int gt = blockIdx.x * 512 + tid, NGT = gridDim.x * 512;
    const bf16_t* E = (const bf16_t*)(p.ws + WS_E); bf16_t* act = (bf16_t*)(p.ws + WS_ACT); const float* cw = p.in[I_CW]; const float* cb = p.in[I_CB];
    for (int idx = gt; idx < 256 * 2 * (DFF / 4); idx += NGT) {
        const int j = (idx % (DFF / 4)) * 4, which = (idx / (DFF / 4)) & 1, pm = idx / (2 * (DFF / 4));
        const bool seq_first = pm < 128 ? (pm % 16 == 0) : ((pm - 128) % 8 == 0), seq_last = pm < 128 ? (pm % 16 == 15) : ((pm - 128) % 8 == 7);
        const int ec = (j >> 7) * 256 + (j & 127);
        const f32x4 z4 = {0.f, 0.f, 0.f, 0.f};
        f32x4 ap, ac, an, bp, bc, bn;
        auto ld = [&](int tile, int slot, int coff) { return unpk4(*(const u32x2*)(E + ((size_t)tile * 4 + slot) * NUP + ec + coff)); };
        if (which == 0) { ac = ld(pm, 0, 0); bc = ld(pm, 0, 128); an = ld(pm, 1, 0); bn = ld(pm, 1, 128);
            if (seq_first) { ap = z4; bp = z4; } else { ap = ld(pm - 1, 3, 0); bp = ld(pm - 1, 3, 128); } }
        else { ap = ld(pm, 2, 0); bp = ld(pm, 2, 128); ac = ld(pm, 3, 0); bc = ld(pm, 3, 128);
            if (seq_last) { an = z4; bn = z4; } else { an = ld(pm + 1, 0, 0); bn = ld(pm + 1, 0, 128); } }
        const f32x4 wa0 = *(const f32x4*)(cw + j), wa1 = *(const f32x4*)(cw + NUP + j), wa2 = *(const f32x4*)(cw + 2 * NUP + j), ba = *(const f32x4*)(cb + j);
        const f32x4 wb0 = *(const f32x4*)(cw + DFF + j), wb1 = *(const f32x4*)(cw + NUP + DFF + j), wb2 = *(const f32x4*)(cw + 2 * NUP + DFF + j), bb = *(const f32x4*)(cb + DFF + j);
        f32x4 r;
#pragma unroll
        for (int e = 0; e < 4; ++e) {
            const float av = wa0[e] * ap[e] + wa1[e] * ac[e] + wa2[e] * an[e] + ba[e];
            const float bv = wb0[e] * bp[e] + wb1[e] * bc[e] + wb2[e] * bn[e] + bb[e];
            r[e] = gelu_tanh(av) * bv;
        }
        const size_t tok = (size_t)pm * 256 + (which ? 255 : 0);
        *(u32x2*)(act + tok * DFF + j) = pk4(r);
    }
}
__device__ __forceinline__ void final_phase(const Params& p, int lane, int wave) {
    const int gw = blockIdx.x * 8 + wave, NGW = gridDim.x * 8;
    const float* rowsq2 = (const float*)(p.ws + WS_ROWSQ2); const bf16_t* y2 = (const bf16_t*)(p.ws + WS_XB);
    f32x4 g[4];
#pragma unroll
    for (int j = 0; j < 4; ++j) g[j] = *(const f32x4*)(p.in[I_GFPOST] + 4 * (lane + 64 * j));
    for (int tok = gw; tok < M; tok += NGW) {
        f32x4* orow = (f32x4*)(p.out + (size_t)tok * D) + lane; const u32x2* yr = (const u32x2*)(y2 + (size_t)tok * D) + lane;
        const float rstd = rsqrtf(rowsq2[tok] * (1.0f / D) + EPS);
#pragma unroll
        for (int j = 0; j < 4; ++j) { const f32x4 yv = unpk4(yr[64 * j]); orow[64 * j] = orow[64 * j] + yv * rstd * g[j]; }
    }
}

#define GAS __attribute__((address_space(1)))
#define XB_TMO      128
#define XB_XCNT(j)  (256  + 64 * (j))
#define XB_XSUB(j)  (1280 + 64 * (j))
#define XB_XGEN(j)  (2304 + 64 * (j))
#define XB_TOP      3328
#define XB_TOPGEN   3392
#define XCD_BAR_WORDS 3456
#define XB_SPIN_CAP (1u << 18)

__device__ __forceinline__ unsigned xb_ld(unsigned* p)              { return __hip_atomic_load(p, __ATOMIC_RELAXED, __HIP_MEMORY_SCOPE_AGENT); }
__device__ __forceinline__ unsigned xb_add(unsigned* p, unsigned v) { return __hip_atomic_fetch_add(p, v, __ATOMIC_RELAXED, __HIP_MEMORY_SCOPE_AGENT); }
__device__ __forceinline__ unsigned xb_xcc_id() { return (unsigned)__builtin_amdgcn_s_getreg((3 << 11) | 20) & 0xFu; }
#define XB_SPIN(cond, bar) do { unsigned _sp = 0; while (cond) { __builtin_amdgcn_s_sleep(1); \
    if ((++_sp & 255u) == 0u) { if (xb_ld(&(bar)[XB_TMO])) break; if (_sp > XB_SPIN_CAP) { atomicAdd(&(bar)[XB_TMO], 1u); break; } } } } while (0)

struct XcdBarrier {
    unsigned* bar; unsigned x;
    volatile LAS unsigned* st;
};

__device__ __forceinline__ XcdBarrier xcd_barrier_post(unsigned* bar, volatile LAS unsigned* st) {
    XcdBarrier b; b.bar = bar; b.x = xb_xcc_id(); b.st = st;
    if (threadIdx.x == 0) (void)xb_add(&bar[XB_XCNT(b.x)], 1u);
    return b;
}
__device__ __forceinline__ void xcd_barrier_complete(unsigned* bar, unsigned x, unsigned& nloc, unsigned& nx) {
    const unsigned G = gridDim.x * gridDim.y * gridDim.z;
    unsigned sum, cnt, mine, sp = 0u;
    for (;;) {
        sum = 0u; cnt = 0u; mine = 0u;
#pragma unroll
        for (unsigned j = 0; j < 16; ++j) { const unsigned c = xb_ld(&bar[XB_XCNT(j)]); sum += c; cnt += (c > 0u) ? 1u : 0u; mine = (j == x) ? c : mine; }
        if (sum == G) break;
        __builtin_amdgcn_s_sleep(1);
        if ((++sp & 255u) == 0u) { if (xb_ld(&bar[XB_TMO])) break; if (sp > XB_SPIN_CAP) { atomicAdd(&bar[XB_TMO], 1u); break; } }
    }
    nloc = mine > 0u ? mine : 1u; nx = cnt > 0u ? cnt : 1u;
}

__device__ __forceinline__ void xcd_barrier(const XcdBarrier& b) {
    asm volatile("s_waitcnt vmcnt(0)" ::: "memory");
    __syncthreads();
    if (threadIdx.x == 0) {
        unsigned* bar = b.bar;
        __builtin_amdgcn_s_waitcnt(0);
        unsigned nloc = b.st[0], nx = b.st[1];
        if (nloc == 0u) { xcd_barrier_complete(bar, b.x, nloc, nx); b.st[0] = nloc; b.st[1] = nx; }
        const unsigned old = xb_add(&bar[XB_XSUB(b.x)], 1u);
        const unsigned gen = old / nloc;
        if (old + 1u == (gen + 1u) * nloc) {
            __builtin_amdgcn_fence(__ATOMIC_RELEASE, "agent");
            asm volatile("s_waitcnt vmcnt(0)" ::: "memory");
            const unsigned og = xb_add(&bar[XB_TOP], 1u);
            const unsigned tg = og / nx;
            if (og + 1u == (tg + 1u) * nx) xb_add(&bar[XB_TOPGEN], 1u);
            else XB_SPIN(xb_ld(&bar[XB_TOPGEN]) == tg, bar);
            __builtin_amdgcn_fence(__ATOMIC_ACQUIRE, "agent");
            xb_add(&bar[XB_XGEN(b.x)], 1u);
            asm volatile("s_waitcnt vmcnt(0)" ::: "memory");
        } else {
            XB_SPIN(xb_ld(&bar[XB_XGEN(b.x)]) == gen, bar);
            __builtin_amdgcn_fence(__ATOMIC_ACQUIRE, "agent");
            asm volatile("s_waitcnt vmcnt(0)" ::: "memory");
        }
    }
    __syncthreads();
}

constexpr int NPHASE = 14;
#ifndef PHMASK
#define PHMASK 0x3fff
#endif
typedef const __attribute__((address_space(4))) Params* KArgs;
__device__ __forceinline__ Params load_params(KArgs q) { Params p;
#pragma unroll
    for (int i = 0; i < 25; ++i) p.in[i] = q->in[i];
    p.out = q->out; p.ws = q->ws; p.ph_lo = q->ph_lo; p.ph_hi = q->ph_hi; return p; }
#define PHASE_ARGS() KArgs q_ = kp; asm volatile("" : "+s"(q_)); const Params p = load_params(q_); unsigned char* ws = p.ws; unsigned char* ob = (unsigned char*)p.out; bf16_t* xb = (bf16_t*)(ws + WS_XB); (void)ob; (void)xb
__global__ void __launch_bounds__(512, 2) fwd_kernel(Params parg) {
    extern __shared__ __attribute__((aligned(16))) unsigned char lds_raw[];
    LAS unsigned char* lds = (LAS unsigned char*)lds_raw;
    const int tid = threadIdx.x, lane = tid & 63, wave = __builtin_amdgcn_readfirstlane(tid >> 6);
    const int G = gridDim.x, blk = blockIdx.x;
    KArgs kp = (KArgs)__builtin_amdgcn_kernarg_segment_ptr();
    const int ph_lo = kp->ph_lo, ph_hi = kp->ph_hi;
    cg::grid_group grid = cg::this_grid();
    volatile LAS unsigned* bar_st = (volatile LAS unsigned*)(lds + LDS_BAR);
    if (tid == 0) { bar_st[0] = 0u; bar_st[1] = 0u; }
    __syncthreads();
    XcdBarrier xbar = xcd_barrier_post((unsigned*)(kp->ws + WS_CTL), bar_st);
#ifndef REPMASK
#define REPMASK 0
#endif
#define IN(k) (((PHMASK >> (k)) & 1) && ph_lo <= (k) && (k) < ph_hi)
#define REPS(k) for (int rep_ = 0; rep_ <= ((REPMASK >> (k)) & 1); ++rep_, (((REPMASK >> (k)) & 1) && rep_ == 1 ? grid.sync() : (void)0))
#define SEAM(k) do { if (ph_lo <= (k) && (k) + 1 < ph_hi) { if ((k) == 0) grid.sync(); else xcd_barrier(xbar); } } while (0)

    if (IN(0)) REPS(0) { PHASE_ARGS(); phase0_prep(p, lds, tid, lane, wave); } SEAM(0);
    if (IN(1)) REPS(1) { PHASE_ARGS();
        pg8::Gemm g{xb, (const bf16_t*)(ws + WS_WIN1)}; pg8::Order<M / 256, 8, 1> S; S.init(G, blk);
        EpiQKVU E{(bf16_t*)(ws + WS_Q), (bf16_t*)(ws + WS_K), (bf16_t*)(ws + WS_VT), (bf16_t*)(ws + WS_AG)};
        pg8::gemm_phase<1024, 1024, 1024, 0, 0>(lds, g, S, E);
    } SEAM(1);
    if (IN(2)) REPS(2) { PHASE_ARGS();
        attn_phase((const bf16_t*)(ws + WS_Q), (const bf16_t*)(ws + WS_K), (const bf16_t*)(ws + WS_VT), (bf16_t*)(ob + OUT_ATT), p.in[I_RPB], lds, tid, wave, lane);
        __syncthreads();
        pg8::Gemm g{(const bf16_t*)(ws + WS_AG), (const bf16_t*)(ws + WS_PSSM)}; pg8::Order<NCH / 256, 1, NG> S; S.init(G, blk);
        EpiLocal E{(float*)(ob + OUT_L)};
        pg8::gemm_phase<512, KS, 512, (long)NCH * KS, 256L * 512>(lds, g, S, E);
    } SEAM(2);
    if (IN(3)) REPS(3) { PHASE_ARGS(); scan_phase(p, (const float*)(ob + OUT_L), (bf16_t*)(ws + WS_AG), tid); } SEAM(3);
    if (IN(4)) REPS(4) { PHASE_ARGS();
        pg8::Gemm g{(const bf16_t*)(ws + WS_AG), (const bf16_t*)(ws + WS_WSSM)}; pg8::Order<NCH / 256, 2, NG> S; S.init(G, blk);
        EpiSsmOut E{(bf16_t*)(ob + OUT_Y)};
        pg8::gemm_phase<KS, KS, KS, (long)NCH * KS, 512L * KS>(lds, g, S, E);
    } SEAM(4);
    if (IN(5)) REPS(5) { PHASE_ARGS();
        pg8::Gemm g{(const bf16_t*)(ob + OUT_Y), (const bf16_t*)(ws + WS_WGLU)}; pg8::Order<M / 256, 2, 1> S; S.init(G, blk);
        EpiGlu E{(const bf16_t*)(ob + OUT_Y), p.in[I_BGLU], (bf16_t*)(ob + OUT_ATT) + (size_t)M * 512};
        pg8::gemm_phase<512, 512, 512, 0, 0>(lds, g, S, E);
    } SEAM(5);
    if (IN(6)) REPS(6) { PHASE_ARGS();
        pg8::Gemm g{(const bf16_t*)(ob + OUT_ATT), (const bf16_t*)(ws + WS_WBR)}; pg8::Order<M / 256, 4, 2> S; S.init(G, blk);
        EpiT E{(bf16_t*)(ws + WS_T)};
        pg8::gemm_phase<512, 512, 512, (long)M * 512, 1024L * 512>(lds, g, S, E);
    } SEAM(6);
    if (IN(7)) REPS(7) { PHASE_ARGS();
        pg8::Gemm g{xb, (const bf16_t*)(ws + WS_WG)}; pg8::Order<M / 256, 8, 1> S; S.init(G, blk);
        EpiGate E{(bf16_t*)(ws + WS_T)};
        pg8::gemm_phase<1024, 1024, 1024, 0, 0>(lds, g, S, E);
    } SEAM(7);
    if (IN(8)) REPS(8) { PHASE_ARGS();
        pg8::Gemm g{(const bf16_t*)(ws + WS_T), (const bf16_t*)(ws + WS_WOUT)}; pg8::Order<M / 256, 4, 1> S; S.init(G, blk);
        EpiOutF32 E{p.out, (float*)(ws + WS_ROWSQ1)};
        pg8::gemm_phase<1024, 1024, 1024, 0, 0>(lds, g, S, E);
    } SEAM(8);
    if (IN(9)) REPS(9) { PHASE_ARGS(); norm_phase(p, lane, wave); } SEAM(9);
    if (IN(10)) REPS(10) { PHASE_ARGS();
        pg8::Gemm g{xb, (const bf16_t*)(ws + WS_WUP)}; pg8::Order<M / 256, NUP / 256, 1> S; S.init(G, blk);
        EpiUp E{(bf16_t*)(ws + WS_ACT), (bf16_t*)(ws + WS_E), (const float*)(ws + WS_CWT), (LAS float*)(lds + LDS_X)};
        pg8::gemm_phase<1024, 1024, 1024, 0, 0>(lds, g, S, E);
    } SEAM(10);
    if (IN(11)) REPS(11) { PHASE_ARGS(); fixup_phase(p, tid); } SEAM(11);
    if (IN(12)) REPS(12) { PHASE_ARGS();
        pg8::Gemm g{(const bf16_t*)(ws + WS_ACT), (const bf16_t*)(ws + WS_WDOWN)}; pg8::Order<M / 256, 4, 1> S; S.init(G, blk);
        EpiOutBf16 E{xb, (float*)(ws + WS_ROWSQ2)};
        pg8::gemm_phase<DFF, DFF, DFF, 0, 0>(lds, g, S, E);
    } SEAM(12);
    if (IN(13)) REPS(13) { PHASE_ARGS(); final_phase(p, lane, wave); }
#undef IN
#undef SEAM
}

#ifndef N_LAUNCHES
#define N_LAUNCHES 1
#endif
extern "C" void kernel_launch(void* const* d_in, const int* in_sizes, int n_in, void* d_out, int out_size, void* d_ws, size_t ws_size, hipStream_t stream) {
    static int grid = 0;
    if (grid == 0) {
        if (n_in != 25 || out_size != M * D || ws_size < WS_END) { fprintf(stderr, "kernel_launch: unexpected shapes (n_in %d out %d ws %zu)\n", n_in, out_size, ws_size); grid = -1; return; }
        int dev = 0, cus = 0, per_cu = 0;
        hipGetDevice(&dev); hipDeviceGetAttribute(&cus, hipDeviceAttributeMultiprocessorCount, dev);
        hipFuncSetAttribute((const void*)fwd_kernel, hipFuncAttributeMaxDynamicSharedMemorySize, LDS_BYTES);
        hipOccupancyMaxActiveBlocksPerMultiprocessor(&per_cu, (const void*)fwd_kernel, 512, LDS_BYTES);
        (void)hipGetLastError();
        if (per_cu < 1) { fprintf(stderr, "kernel_launch: occupancy query says %d blocks per CU\n", per_cu); per_cu = 1; }
        grid = cus;
    }
    if (grid < 0) return;
    Params p{};
    for (int i = 0; i < 25; ++i) p.in[i] = (const float*)d_in[i];
    p.out = (float*)d_out; p.ws = (unsigned char*)d_ws;
    if (N_LAUNCHES == 1) {
        if (hipMemsetAsync((char*)d_ws + WS_CTL, 0, 16384, stream) != hipSuccess) { fprintf(stderr, "kernel_launch: memset of the barrier words failed\n"); return; }
        p.ph_lo = 0; p.ph_hi = NPHASE;
        void* args[] = {&p};
        hipError_t e = hipLaunchCooperativeKernel((const void*)fwd_kernel, dim3(grid), dim3(512), args, LDS_BYTES, stream);
        if (e != hipSuccess) fprintf(stderr, "cooperative launch failed: %s (grid %d)\n", hipGetErrorString(e), grid);
    } else {
        for (int k = 0; k < NPHASE; ++k) {
            p.ph_lo = k; p.ph_hi = k + 1;
            hipLaunchKernelGGL(fwd_kernel, dim3(grid), dim3(512), LDS_BYTES, stream, p);
        }
    }
}
```
